# Optimizing an MI355X kernel written in HIP

```python
import math, functools
import jax, jax.numpy as jnp
from jax import lax
import numpy as np

D_MODEL = 1024
BATCH = 16
SEQ = 2048
DEPTH = 4

D_MIX = D_MODEL
HEAD_DIM = 64
ATTN_WIDTH = D_MIX // 2
CONV_WIDTH = D_MIX // 4
POOL_WIDTH = D_MIX - ATTN_WIDTH - CONV_WIDTH
N_ATTN_HEADS = ATTN_WIDTH // HEAD_DIM
POOL_WINDOWS = (2, 4, 8, 16)
N_POOL_GROUPS = len(POOL_WINDOWS)
POOL_GROUP = POOL_WIDTH // N_POOL_GROUPS
CONV_K = 3
MOBA_BLOCK = 256
MOBA_TOP_K = 3
NUM_BUCKETS = 32
MAX_DISTANCE = 1024
D_FF = ((8 * D_MODEL // 3 + 255) // 256) * 256
IN_COLS = 3 * ATTN_WIDTH + 3 * CONV_WIDTH + POOL_WIDTH
DEEPNORM_ALPHA = (2.0 * DEPTH) ** 0.25
DEEPNORM_BETA = (8.0 * DEPTH) ** -0.25
LN_EPS = 1e-5
NEG_INF = -1e30

kernel_name = 'hymba_style_moba_conv_pool_deepnorm'


def layer_norm(x, g, b):
    xf = x.astype(jnp.float32)
    mu = xf.mean(-1, keepdims=True)
    var = jnp.square(xf - mu).mean(-1, keepdims=True)
    return ((xf - mu) * lax.rsqrt(var + LN_EPS)).astype(x.dtype) * g + b


def causal_dwconv(x, w):
    S = x.shape[1]
    xp = jnp.pad(x, ((0, 0), (CONV_K - 1, 0), (0, 0)))
    return sum(xp[:, j:j + S] * w[j] for j in range(CONV_K))


def t5_bucket(dist):
    n = jnp.maximum(dist, 0)
    max_exact = NUM_BUCKETS // 2
    nf = jnp.maximum(n, 1).astype(jnp.float32)
    large = max_exact + (jnp.log(nf / max_exact) / math.log(MAX_DISTANCE / max_exact)
                         * (NUM_BUCKETS - max_exact)).astype(jnp.int32)
    large = jnp.minimum(large, NUM_BUCKETS - 1)
    return jnp.where(n < max_exact, n, large)


def _moba_query_block(i, n_sel, args):
    qh, selh, kh, vh, tab = args
    L = MOBA_BLOCK
    scale = HEAD_DIM ** -0.5
    r = jnp.arange(L)
    rel = r[:, None] - r[None, :]
    own_logits = (jnp.einsum('qd,ld->ql', qh, kh[i]).astype(jnp.float32) * scale
                  + tab[t5_bucket(rel)].astype(jnp.float32))
    own_logits = jnp.where(rel >= 0, own_logits, NEG_INF)
    if n_sel == 0:
        p = jax.nn.softmax(own_logits, axis=-1).astype(vh.dtype)
        return jnp.einsum('ql,ld->qd', p, vh[i])
    k_sel = kh[selh]
    v_sel = vh[selh]
    dist = (i - selh)[:, :, None] * L + rel[:, None, :]
    sel_logits = (jnp.einsum('qd,qnld->qnl', qh, k_sel).astype(jnp.float32) * scale
                  + tab[t5_bucket(dist)].astype(jnp.float32))
    logits = jnp.concatenate([sel_logits.reshape(L, n_sel * L), own_logits], axis=-1)
    p = jax.nn.softmax(logits, axis=-1).astype(vh.dtype)
    p_sel = p[:, :n_sel * L].reshape(L, n_sel, L)
    p_own = p[:, n_sel * L:]
    return jnp.einsum('qnl,qnld->qd', p_sel, v_sel) + jnp.einsum('ql,ld->qd', p_own, vh[i])


def moba_attention(q, k, v, rel_bias):
    B, H, S, Dh = q.shape
    L = MOBA_BLOCK
    nb = -(-S // L)
    pad = nb * L - S
    if pad:
        cfg = ((0, 0), (0, 0), (0, pad), (0, 0))
        q, k, v = jnp.pad(q, cfg), jnp.pad(k, cfg), jnp.pad(v, cfg)
    qb = q.reshape(B, H, nb, L, Dh)
    kb = k.reshape(B, H, nb, L, Dh)
    vb = v.reshape(B, H, nb, L, Dh)
    k_mean = kb.astype(jnp.float32).mean(axis=3).astype(k.dtype)
    k_flat = kb.reshape(B * H, nb, L, Dh)
    v_flat = vb.reshape(B * H, nb, L, Dh)
    tab = jnp.broadcast_to(rel_bias[None], (B,) + rel_bias.shape).reshape(B * H, NUM_BUCKETS)
    outs = []
    for i in range(nb):
        q_i = qb[:, :, i]
        n_sel = min(MOBA_TOP_K, i)
        if n_sel:
            gate = jnp.einsum('bhqd,bhnd->bhqn', q_i, k_mean[:, :, :i]).astype(jnp.float32)
            _, sel = lax.top_k(gate, n_sel)
            sel = sel.reshape(B * H, L, n_sel)
        else:
            sel = jnp.zeros((B * H, L, 0), jnp.int32)
        step = functools.partial(_moba_query_block, i, n_sel)
        outs.append(lax.map(step, (q_i.reshape(B * H, L, Dh), sel, k_flat, v_flat, tab)))
    out = jnp.concatenate(outs, axis=1).reshape(B, H, nb * L, Dh)
    return out[:, :, :S]


def pool_mixer(p, w_pool, pool_scale):
    B, S, _ = p.shape
    pg = p.reshape(B, S, N_POOL_GROUPS, POOL_GROUP)
    pf = pg.astype(jnp.float32)
    c = jnp.cumsum(pf, axis=1)
    pos = jnp.arange(1, S + 1, dtype=jnp.float32)
    means = []
    for g, w in enumerate(POOL_WINDOWS):
        cg = c[:, :, g]
        lag = jnp.pad(cg, ((0, 0), (w, 0), (0, 0)))[:, :S]
        means.append((cg - lag) / jnp.minimum(pos, float(w))[None, :, None])
    pooled = (jnp.stack(means, axis=2) - pf).astype(p.dtype)
    y = jnp.einsum('bsgc,gcd->bsgd', pooled, w_pool)
    return y.reshape(B, S, POOL_WIDTH) * pool_scale


def to_heads(t):
    B, S, _ = t.shape
    return t.reshape(B, S, -1, HEAD_DIM).transpose(0, 2, 1, 3)


def hybrid_layer(x, w_in, conv_w, w_pool, pool_scale, w_out, ln1_g, ln1_b,
                 w_up, ffn_conv_w, ffn_conv_b, w_down, ln2_g, ln2_b, rel_bias):
    B, S, _ = x.shape
    h = x @ w_in
    sizes = [ATTN_WIDTH, ATTN_WIDTH, ATTN_WIDTH, CONV_WIDTH, CONV_WIDTH, CONV_WIDTH]
    q, k, v, cb, cc, cx, pin = jnp.split(h, list(np.cumsum(sizes)), axis=-1)
    attn = moba_attention(to_heads(q), to_heads(k), to_heads(v), rel_bias)
    attn = attn.transpose(0, 2, 1, 3).reshape(B, S, ATTN_WIDTH)
    conv = cb * causal_dwconv(cc * cx, conv_w)
    pool = pool_mixer(pin, w_pool, pool_scale)
    mix = jnp.concatenate([attn, conv, pool], axis=-1) @ w_out
    x = layer_norm(DEEPNORM_ALPHA * x + mix, ln1_g, ln1_b)
    up = causal_dwconv(x @ w_up, ffn_conv_w) + ffn_conv_b
    u, g = jnp.split(up, 2, axis=-1)
    ff = (u * jax.nn.silu(g)) @ w_down
    return layer_norm(DEEPNORM_ALPHA * x + ff, ln2_g, ln2_b)


def setup_inputs(seed: int = 0) -> dict:
    key = jax.random.key(seed)
    ks = jax.random.split(key, 16)
    nrm = jax.random.normal
    return {
        'x': nrm(ks[0], (BATCH, SEQ, D_MODEL), jnp.float32),
        'w_in': nrm(ks[1], (DEPTH, D_MODEL, IN_COLS), jnp.float32) * D_MODEL ** -0.5,
        'conv_w': nrm(ks[2], (DEPTH, CONV_K, CONV_WIDTH), jnp.float32) * CONV_K ** -0.5,
        'w_pool': nrm(ks[3], (DEPTH, N_POOL_GROUPS, POOL_GROUP, POOL_GROUP), jnp.float32) * POOL_GROUP ** -0.5,
        'pool_scale': 1.0 + 0.02 * nrm(ks[4], (DEPTH, POOL_WIDTH), jnp.float32),
        'w_out': nrm(ks[5], (DEPTH, D_MIX, D_MODEL), jnp.float32) * (D_MIX ** -0.5 * DEEPNORM_BETA),
        'ln1_g': 1.0 + 0.02 * nrm(ks[6], (DEPTH, D_MODEL), jnp.float32),
        'ln1_b': 0.02 * nrm(ks[7], (DEPTH, D_MODEL), jnp.float32),
        'w_up': nrm(ks[8], (DEPTH, D_MODEL, 2 * D_FF), jnp.float32) * D_MODEL ** -0.5,
        'ffn_conv_w': nrm(ks[9], (DEPTH, CONV_K, 2 * D_FF), jnp.float32) * CONV_K ** -0.5,
        'ffn_conv_b': 0.02 * nrm(ks[10], (DEPTH, 2 * D_FF), jnp.float32),
        'w_down': nrm(ks[11], (DEPTH, D_FF, D_MODEL), jnp.float32) * (D_FF ** -0.5 * DEEPNORM_BETA),
        'ln2_g': 1.0 + 0.02 * nrm(ks[12], (DEPTH, D_MODEL), jnp.float32),
        'ln2_b': 0.02 * nrm(ks[13], (DEPTH, D_MODEL), jnp.float32),
        'rel_bias': 0.5 * nrm(ks[14], (N_ATTN_HEADS, NUM_BUCKETS), jnp.float32),
    }


def reference(x, w_in, conv_w, w_pool, pool_scale, w_out, ln1_g, ln1_b,
              w_up, ffn_conv_w, ffn_conv_b, w_down, ln2_g, ln2_b, rel_bias):
    for l in range(DEPTH):
        x = hybrid_layer(x, w_in[l], conv_w[l], w_pool[l], pool_scale[l], w_out[l],
                         ln1_g[l], ln1_b[l], w_up[l], ffn_conv_w[l], ffn_conv_b[l],
                         w_down[l], ln2_g[l], ln2_b[l], rel_bias)
    return x
```

```cpp
#include <hip/hip_runtime.h>
#include <hip/hip_cooperative_groups.h>
#include <cstdio>
#include <cstdint>
namespace cg = cooperative_groups;
namespace pg8 {
#define PG8_LAS __attribute__((address_space(3)))
typedef unsigned short bf16_t;
typedef short bf16x8 __attribute__((ext_vector_type(8)));
typedef float f32x4 __attribute__((ext_vector_type(4)));
typedef unsigned u32x4 __attribute__((ext_vector_type(4)));
constexpr int BM = 256, BK = 64, HALF = 128, HTB = HALF * BK * 2  , STAGE_BYTES = 8 * HTB, NXCD = 8, WGM = 8;

__host__ __device__ __forceinline__ int lds_byte(int r, int c) { const int st = (r >> 4) * 2 + (c >> 5), rr = r & 15, cc = c & 31, ob = rr * 64 + cc * 2; return st * 1024 + (ob ^ (((ob >> 9) & 1) << 5)); }
__host__ __device__ __forceinline__ void stage_rc(int b, int& R, int& C) { const int st = b / 1024, sb = b % 1024, swz = sb ^ (((sb >> 9) & 1) << 5); R = (st >> 1) * 16 + swz / 64; C = (st & 1) * 32 + (swz % 64) / 2; }
__host__ __device__ __forceinline__ int perm32(int rho) { const int n = rho >> 4, i = rho & 15; return 8 * (i >> 2) + 4 * n + (i & 3); }

struct Unit { int pm, pn; };
struct Gemm { const bf16_t* A; const bf16_t* Bt; int M, N, K; };

struct StaticOrder {
    int nM, nN, nwg, G, c;
    __host__ __device__ void init(int M, int N, int G_, int c_) { nM = M / BM; nN = N / BM; nwg = nM * nN; G = G_; c = c_; }
    __host__ __device__ bool next(int i, Unit& u) const {
        const long L = (long)i * G + c; if (L >= nwg) return false;
        int wgid = (int)L; { const int q = nwg / NXCD, r = nwg % NXCD, xcd = wgid % NXCD, off = wgid / NXCD; wgid = (xcd < r ? xcd * (q + 1) : r * (q + 1) + (xcd - r) * q) + off; }
        const int nig = WGM * nN, gid = wgid / nig, fm = gid * WGM, gsz = (nM - fm) < WGM ? (nM - fm) : WGM;
        u.pm = fm + ((wgid % nig) % gsz); u.pn = (wgid % nig) / gsz; return true;
    }
    __device__ __forceinline__ void a_ready(const Unit&) const {}
    __device__ __forceinline__ void done(const Unit&) const {}
};

__device__ __forceinline__ unsigned cvt_pk_bf16(float lo, float hi) { unsigned r; asm volatile("v_cvt_pk_bf16_f32 %0, %1, %2" : "=v"(r) : "v"(lo), "v"(hi)); return r; }
typedef float f32x2 __attribute__((ext_vector_type(2)));
template <class Epi, class Sched, bool ALIGN_EPI = false, bool SP2 = false>
__device__ __forceinline__ void gemm_phase(PG8_LAS unsigned char* lds, const Gemm g, const Sched& S, const Epi& E) {
    int tid_ = threadIdx.x; asm volatile("" : "+v"(tid_));
    const int tid = tid_, wid = __builtin_amdgcn_readfirstlane(tid >> 6), lane = tid & 63, wr = wid >> 2, wc = wid & 3, fr = lane & 15, fq = lane >> 4;
    const int K = g.K, nt = K / BK;
    unsigned voffA[2], voffB[2];
#pragma unroll
    for (int i = 0; i < 2; ++i) { int R, C; stage_rc(tid * 16 + i * 8192, R, C); const int Rb = Epi::PERM ? ((R & ~31) + perm32(R & 31)) : R;
        voffA[i] = (unsigned)(R * K + C) * 2u; voffB[i] = (unsigned)(Rb * K + C) * 2u; }
    const size_t kstep = (size_t)(BK * 2);
    const size_t hstep = (size_t)HALF * K * 2;
    const size_t tstep = 2 * hstep;
    const unsigned ldsw = (unsigned)wid * 1024u;
    const int aoff = lds_byte(wr * 64 + fr, fq * 8), boff = lds_byte(wc * 32 + fr, fq * 8);
#define PG8_SA(b, h) (((b) * 2 + (h)) * HTB)
#define PG8_SB(b, h) ((4 + (b) * 2 + (h)) * HTB)
#define PG8_STAGE(bufoff, gbase, voff) do { _Pragma("unroll") for (int _i = 0; _i < 2; ++_i) \
        __builtin_amdgcn_global_load_lds((const unsigned*)((const char*)(gbase) + (voff)[_i]), (PG8_LAS unsigned*)(lds + (bufoff) + ldsw + _i * 8192), 16, 0, 0); } while (0)
#define PG8_LDA(dst, b, h) do { _Pragma("unroll") for (int m = 0; m < 4; ++m) _Pragma("unroll") for (int k = 0; k < 2; ++k) dst[m][k] = *(const PG8_LAS bf16x8*)(lds + PG8_SA(b, h) + aoff + m * 2048 + k * 1024); } while (0)
#define PG8_LDB(dst, b, h) do { _Pragma("unroll") for (int n = 0; n < 2; ++n) _Pragma("unroll") for (int k = 0; k < 2; ++k) dst[n][k] = *(const PG8_LAS bf16x8*)(lds + PG8_SB(b, h) + boff + n * 2048 + k * 1024); } while (0)
#define PG8_MMA(ai, bj, At, Bt) do { __builtin_amdgcn_s_setprio(1); _Pragma("unroll") for (int m = 0; m < 4; ++m) _Pragma("unroll") for (int n = 0; n < 2; ++n) _Pragma("unroll") for (int k = 0; k < 2; ++k) \
        acc[ai][bj][m][n] = __builtin_amdgcn_mfma_f32_16x16x32_bf16(Bt[n][k], At[m][k], acc[ai][bj][m][n], 0, 0, 0); __builtin_amdgcn_s_setprio(0); } while (0)
#define PG8_WAIT_V(n) asm volatile("s_waitcnt vmcnt(" #n ")" ::: "memory")
#define PG8_WAIT_L(n) asm volatile("s_waitcnt lgkmcnt(" #n ")" ::: "memory")
#define PG8_BAR __builtin_amdgcn_s_barrier()
#define PG8_SCHED __builtin_amdgcn_sched_barrier(0)
    Unit cur, nxt; int ui = 0;
    if (!S.next(0, cur)) return;
    f32x4 acc[2][2][4][2];
#pragma unroll
    for (int a = 0; a < 2; ++a)
#pragma unroll
        for (int b = 0; b < 2; ++b)
#pragma unroll
            for (int m = 0; m < 4; ++m)
#pragma unroll
                for (int n = 0; n < 2; ++n) acc[a][b][m][n] = (f32x4){0.f, 0.f, 0.f, 0.f};
    bf16x8 At[4][2], B0[2][2], B1[2][2];
    const char* cA = (const char*)g.A + (size_t)cur.pm * tstep; const char* cB = (const char*)g.Bt + (size_t)cur.pn * tstep;
    S.a_ready(cur);
    if constexpr (SP2) {
        PG8_STAGE(PG8_SB(0, 0), cB, voffB); PG8_STAGE(PG8_SB(0, 1), cB + hstep, voffB); PG8_STAGE(PG8_SA(0, 0), cA, voffA); PG8_STAGE(PG8_SA(0, 1), cA + hstep, voffA);
        if (wr == 1) PG8_BAR;
        PG8_WAIT_V(2); PG8_BAR;
        PG8_STAGE(PG8_SB(1, 0), cB + kstep, voffB); PG8_STAGE(PG8_SA(1, 0), cA + kstep, voffA); PG8_STAGE(PG8_SB(1, 1), cB + hstep + kstep, voffB);
        PG8_WAIT_V(6); PG8_BAR;
    } else {
        PG8_STAGE(PG8_SB(0, 0), cB, voffB); PG8_STAGE(PG8_SA(0, 0), cA, voffA); PG8_STAGE(PG8_SB(0, 1), cB + hstep, voffB); PG8_STAGE(PG8_SA(0, 1), cA + hstep, voffA);
        if (wr == 1) PG8_BAR;
        PG8_WAIT_V(4); PG8_BAR;
        PG8_STAGE(PG8_SB(1, 0), cB + kstep, voffB); PG8_STAGE(PG8_SA(1, 0), cA + kstep, voffA); PG8_STAGE(PG8_SB(1, 1), cB + hstep + kstep, voffB);
        PG8_WAIT_V(6); PG8_BAR;
    }
    for (;;) {
        const bool has_next = S.next(ui + 1, nxt);
        const char* nA = has_next ? (const char*)g.A + (size_t)nxt.pm * tstep : cA; const char* nB = has_next ? (const char*)g.Bt + (size_t)nxt.pn * tstep : cB;
        for (int t = 0; t < nt; t += 2) {
            const bool last = (t == nt - 2);
            const char* a1 = cA + (size_t)(t + 1) * kstep;
            const char* a2 = last ? nA : cA + (size_t)(t + 2) * kstep; const char* b2 = last ? nB : cB + (size_t)(t + 2) * kstep;
            const char* a3 = a2 + kstep; const char* b3 = b2 + kstep;
            if (last && has_next) S.a_ready(nxt);
            if constexpr (SP2) {
            PG8_LDB(B0, 0, 0); PG8_LDB(B1, 0, 1); PG8_SCHED; PG8_LDA(At, 0, 0); PG8_STAGE(PG8_SA(1, 1), a1 + hstep, voffA);
            PG8_WAIT_V(8); PG8_WAIT_L(0); PG8_BAR; PG8_MMA(0, 0, At, B0); PG8_MMA(0, 1, At, B1); PG8_BAR; PG8_SCHED;
            PG8_LDA(At, 0, 1); PG8_STAGE(PG8_SB(0, 0), b2, voffB); PG8_STAGE(PG8_SB(0, 1), b2 + hstep, voffB); PG8_STAGE(PG8_SA(0, 0), a2, voffA);
            PG8_WAIT_V(8); PG8_WAIT_L(0); PG8_BAR; PG8_MMA(1, 0, At, B0); PG8_MMA(1, 1, At, B1); PG8_BAR; PG8_SCHED;
            PG8_LDB(B0, 1, 0); PG8_LDB(B1, 1, 1); PG8_SCHED; PG8_LDA(At, 1, 0); PG8_STAGE(PG8_SA(0, 1), a2 + hstep, voffA);
            PG8_WAIT_V(8); PG8_WAIT_L(0); PG8_BAR; PG8_MMA(0, 0, At, B0); PG8_MMA(0, 1, At, B1); PG8_BAR; PG8_SCHED;
            PG8_LDA(At, 1, 1); PG8_STAGE(PG8_SB(1, 0), b3, voffB); PG8_STAGE(PG8_SB(1, 1), b3 + hstep, voffB); PG8_STAGE(PG8_SA(1, 0), a3, voffA);
            PG8_WAIT_V(8); PG8_WAIT_L(0); PG8_BAR; PG8_MMA(1, 0, At, B0); PG8_MMA(1, 1, At, B1); PG8_BAR; PG8_SCHED;
            } else {
            PG8_LDB(B0, 0, 0); PG8_SCHED; PG8_LDA(At, 0, 0); PG8_STAGE(PG8_SA(1, 1), a1 + hstep, voffA);
            PG8_WAIT_L(8); PG8_BAR; PG8_WAIT_L(0); PG8_MMA(0, 0, At, B0); PG8_BAR; PG8_SCHED;
            PG8_LDB(B1, 0, 1); PG8_STAGE(PG8_SB(0, 0), b2, voffB);
            PG8_BAR; PG8_WAIT_L(0); PG8_MMA(0, 1, At, B1); PG8_BAR;
            PG8_LDA(At, 0, 1); PG8_STAGE(PG8_SA(0, 0), a2, voffA);
            PG8_BAR; PG8_WAIT_L(0); PG8_MMA(1, 0, At, B0); PG8_BAR; PG8_SCHED;
            PG8_STAGE(PG8_SB(0, 1), b2 + hstep, voffB);
            PG8_WAIT_V(6); PG8_BAR; PG8_MMA(1, 1, At, B1); PG8_BAR;
            PG8_LDB(B0, 1, 0); PG8_SCHED; PG8_LDA(At, 1, 0); PG8_STAGE(PG8_SA(0, 1), a2 + hstep, voffA);
            PG8_WAIT_L(8); PG8_BAR; PG8_WAIT_L(0); PG8_MMA(0, 0, At, B0); PG8_BAR; PG8_SCHED;
            PG8_LDB(B1, 1, 1); PG8_STAGE(PG8_SB(1, 0), b3, voffB);
            PG8_BAR; PG8_WAIT_L(0); PG8_MMA(0, 1, At, B1); PG8_BAR;
            PG8_LDA(At, 1, 1); PG8_STAGE(PG8_SA(1, 0), a3, voffA);
            PG8_BAR; PG8_WAIT_L(0); PG8_MMA(1, 0, At, B0); PG8_BAR; PG8_SCHED;
            PG8_STAGE(PG8_SB(1, 1), b3 + hstep, voffB);
            PG8_WAIT_V(6); PG8_BAR; PG8_MMA(1, 1, At, B1); PG8_BAR;
            }
        }
        if constexpr (ALIGN_EPI) { if (wr == 0) PG8_BAR; }
        if constexpr (!Epi::AFTER_DRAIN) { E(acc, cur, wr, wc, fr, fq); S.done(cur); }
        if (!has_next) break;
#pragma unroll
        for (int a = 0; a < 2; ++a)
#pragma unroll
            for (int b = 0; b < 2; ++b)
#pragma unroll
                for (int m = 0; m < 4; ++m)
#pragma unroll
                    for (int n = 0; n < 2; ++n) acc[a][b][m][n] = (f32x4){0.f, 0.f, 0.f, 0.f};
        cur = nxt; cA = nA; cB = nB; ++ui;
        if constexpr (ALIGN_EPI) { if (wr == 1) PG8_BAR; }
    }
    PG8_WAIT_V(0);
    if constexpr (!ALIGN_EPI) { if (wr == 0) PG8_BAR; }
    PG8_BAR;
    if constexpr (Epi::AFTER_DRAIN) { E.fused(acc, cur, wr, wc, fr, fq, lds, wid, lane); S.done(cur); }
#undef PG8_SA
#undef PG8_SB
#undef PG8_STAGE
#undef PG8_LDA
#undef PG8_LDB
#undef PG8_MMA
#undef PG8_WAIT_V
#undef PG8_WAIT_L
#undef PG8_BAR
#undef PG8_SCHED
}
}
#define LAS __attribute__((address_space(3)))
typedef unsigned short bf16_t;
typedef short bf16x8 __attribute__((ext_vector_type(8)));
typedef float f32x4 __attribute__((ext_vector_type(4)));
typedef float f32x16 __attribute__((ext_vector_type(16)));
typedef unsigned u32x4 __attribute__((ext_vector_type(4)));
typedef unsigned u32x2 __attribute__((ext_vector_type(2)));

constexpr int BATCH = 16, SEQ = 2048, DM = 1024, DEPTH = 4, MTOK = BATCH * SEQ;
constexpr int NIN = 2560, DFF = 2816, NUP = 5632;
constexpr float ALPHA = 1.6817928305074292f;
constexpr float LN_EPS = 1e-5f;
constexpr float LOG2E = 1.4426950408889634f;
constexpr float C2 = 0.125f * 1.4426950408889634f;
constexpr float NEGBIG = -1e30f;
constexpr int NWAVES = 8, NTHREADS = 512;
constexpr int LDS_BYTES = 160 * 1024;

constexpr size_t MiB = 1u << 20;
constexpr size_t WS_WIN = 0, WS_WOUT = 20 * MiB, WS_WUP = 28 * MiB, WS_WDN = 72 * MiB, WS_XB = 96 * MiB, WS_H = 160 * MiB, WS_A2 = 320 * MiB,
                 WS_ACT = 160 * MiB, WS_VT = 384 * MiB, WS_Z4 = 416 * MiB, WS_KP = 460 * MiB, WS_MIX = 384 * MiB  , WS_END = 461 * MiB;
constexpr size_t WIN_L = (size_t)NIN * DM, WOUT_L = (size_t)DM * DM, WUP_L = (size_t)NUP * DM, WDN_L = (size_t)DM * DFF;

struct Args {
    const float *x, *w_in, *conv_w, *w_pool, *pool_scale, *w_out, *ln1_g, *ln1_b, *w_up, *ffn_conv_w, *ffn_conv_b, *w_down, *ln2_g, *ln2_b, *rel_bias;
    float* out; unsigned char* ws;
};

__device__ __forceinline__ unsigned f2bf(float f) { unsigned u = __builtin_bit_cast(unsigned, f); return (u + 0x7fffu + ((u >> 16) & 1u)) >> 16; }
__device__ __forceinline__ unsigned pk2(float lo, float hi) { return pg8::cvt_pk_bf16(lo, hi); }
__device__ __forceinline__ float bf2f(unsigned short s) { return __uint_as_float(((unsigned)s) << 16); }
__device__ __forceinline__ float bflo(unsigned w) { return __uint_as_float(w << 16); }
__device__ __forceinline__ float bfhi(unsigned w) { return __uint_as_float(w & 0xffff0000u); }
__device__ __forceinline__ float wave_sum(float v) {
#pragma unroll
    for (int o = 1; o < 64; o <<= 1) v += __shfl_xor(v, o);
    return v;
}

__device__ __forceinline__ void transpose_item(const float* W, int K, int N, bf16_t* WT, int k0, int n0, int row0, LAS float* scr, int lane) {
#pragma unroll 8
    for (int i = 0; i < 32; ++i) { const int kk = 2 * i + (lane >> 5); scr[kk * 33 + (lane & 31)] = W[(size_t)(k0 + kk) * N + n0 + (lane & 31)]; }
    asm volatile("s_waitcnt lgkmcnt(0)" ::: "memory");
    const int c = lane & 7;
#pragma unroll
    for (int j = 0; j < 4; ++j) { const int n = (lane >> 3) + 8 * j; const LAS float* s = scr + (8 * c) * 33 + n;
        u32x4 o; o.x = pk2(s[0 * 33], s[1 * 33]); o.y = pk2(s[2 * 33], s[3 * 33]); o.z = pk2(s[4 * 33], s[5 * 33]); o.w = pk2(s[6 * 33], s[7 * 33]);
        *(u32x4*)(WT + (size_t)(row0 + n) * K + k0 + 8 * c) = o; }
    asm volatile("s_waitcnt lgkmcnt(0)" ::: "memory");
}
__device__ __forceinline__ int up_row(int n0) { int ch = n0 < DFF ? n0 : n0 - DFF; return 256 * (ch >> 7) + (ch & 127) + (n0 < DFF ? 0 : 128); }

__device__ __forceinline__ void prologue(const Args& a, LAS unsigned char* lds, int gw, int NGW, int wave, int lane) {
    LAS float* scr = (LAS float*)(lds + wave * 16384);
    bf16_t* WinT = (bf16_t*)(a.ws + WS_WIN); bf16_t* WoutT = (bf16_t*)(a.ws + WS_WOUT); bf16_t* WupT = (bf16_t*)(a.ws + WS_WUP); bf16_t* WdnT = (bf16_t*)(a.ws + WS_WDN);
    constexpr int I_IN = 16 * 80, I_OUT = 12 * 32, I_UP = 16 * 176, I_DN = 44 * 32, I_L = I_IN + I_OUT + I_UP + I_DN;
    for (int it = gw; it < DEPTH * I_L; it += NGW) {
        const int l = it / I_L; int r = it % I_L;
        if (r < I_IN) { const int kb = r / 80, nb = r % 80; transpose_item(a.w_in + (size_t)l * WIN_L, DM, NIN, WinT + (size_t)l * WIN_L, 64 * kb, 32 * nb, 32 * nb, scr, lane); continue; } r -= I_IN;
        if (r < I_OUT) { const int kb = r / 32, nb = r % 32; transpose_item(a.w_out + (size_t)l * WOUT_L, DM, DM, WoutT + (size_t)l * WOUT_L, 64 * kb, 32 * nb, 32 * nb, scr, lane); continue; } r -= I_OUT;
        if (r < I_UP) { const int kb = r / 176, nb = r % 176; transpose_item(a.w_up + (size_t)l * WUP_L, DM, NUP, WupT + (size_t)l * WUP_L, 64 * kb, 32 * nb, up_row(32 * nb), scr, lane); continue; } r -= I_UP;
        { const int kb = r / 32, nb = r % 32; transpose_item(a.w_down + (size_t)l * WDN_L, DFF, DM, WdnT + (size_t)l * WDN_L, 64 * kb, 32 * nb, 32 * nb, scr, lane); }
    }
    for (int it = gw; it < DEPTH * 256 * 16; it += NGW) {
        const int l = it >> 12, gc = (it >> 4) & 255, n = ((it & 15) << 6) + lane, g = gc >> 6;
        const float* wp = a.w_pool + ((size_t)l * 256 + gc) * 64; const float* ps = a.pool_scale + l * 256 + 64 * g;
        const float* wo = a.w_out + (size_t)l * WOUT_L + (size_t)(768 + 64 * g) * DM + n;
        float acc = 0.f;
#pragma unroll 8
        for (int d = 0; d < 64; ++d) acc += wp[d] * ps[d] * wo[(size_t)d * DM];
        WoutT[(size_t)l * WOUT_L + (size_t)n * DM + 768 + gc] = (bf16_t)f2bf(acc);
    }
    bf16_t* XB = (bf16_t*)(a.ws + WS_XB);
    for (int m = gw; m < MTOK; m += NGW) {
        const f32x4* xr = (const f32x4*)(a.x + (size_t)m * DM) + lane; u32x2* o = (u32x2*)(XB + (size_t)m * DM) + lane;
#pragma unroll
        for (int j = 0; j < 4; ++j) { const f32x4 v = xr[64 * j]; u32x2 w; w.x = pk2(v.x, v.y); w.y = pk2(v.z, v.w); o[64 * j] = w; }
    }
}

__device__ __forceinline__ void ln_pass(const float* X, const bf16_t* MIX, float* Y, const float* g, const float* b, bf16_t* XB, int gw, int NGW, int lane) {
    f32x4 gv[4], bv[4];
#pragma unroll
    for (int j = 0; j < 4; ++j) { gv[j] = ((const f32x4*)g)[lane + 64 * j]; bv[j] = ((const f32x4*)b)[lane + 64 * j]; }
    for (int m = gw; m < MTOK; m += NGW) {
        const f32x4* xr = (const f32x4*)(X + (size_t)m * DM) + lane; const u32x2* mr = (const u32x2*)(MIX + (size_t)m * DM) + lane;
        f32x4* yr = (f32x4*)(Y + (size_t)m * DM) + lane; u32x2* o = (u32x2*)(XB + (size_t)m * DM) + lane;
        f32x4 v[4]; float s = 0.f;
#pragma unroll
        for (int j = 0; j < 4; ++j) { const f32x4 xv = xr[64 * j]; const u32x2 mw = mr[64 * j];
            v[j] = xv * ALPHA + (f32x4){bflo(mw.x), bfhi(mw.x), bflo(mw.y), bfhi(mw.y)}; s += (v[j].x + v[j].y) + (v[j].z + v[j].w); }
        const float mean = wave_sum(s) * (1.f / DM); float s2 = 0.f;
#pragma unroll
        for (int j = 0; j < 4; ++j) { v[j] = v[j] - mean; s2 += (v[j].x * v[j].x + v[j].y * v[j].y) + (v[j].z * v[j].z + v[j].w * v[j].w); }
        const float rstd = 1.f / sqrtf(wave_sum(s2) * (1.f / DM) + LN_EPS);
#pragma unroll
        for (int j = 0; j < 4; ++j) { const f32x4 r = v[j] * rstd * gv[j] + bv[j]; yr[64 * j] = r; u32x2 w; w.x = pk2(r.x, r.y); w.y = pk2(r.z, r.w); o[64 * j] = w; }
    }
}

struct EpiH {
    static constexpr bool PERM = true, AFTER_DRAIN = false;
    bf16_t* H; bf16_t* VT; float* kpart;
    __device__ __forceinline__ void operator()(const pg8::f32x4 (&acc)[2][2][4][2], const pg8::Unit& u, int wr, int wc, int fr, int fq) const {
        const int row0 = u.pm * 256 + wr * 64 + fr; const int colt = u.pn * 256 + wc * 32 + 8 * fq;
        if (u.pn == 4 || u.pn == 5) {
#pragma unroll
            for (int ai = 0; ai < 2; ++ai)
#pragma unroll
                for (int m = 0; m < 4; ++m) { const int row = row0 + ai * 128 + m * 16; const int b = row >> 11, t = row & 2047;
#pragma unroll
                    for (int bj = 0; bj < 2; ++bj)
#pragma unroll
                        for (int n = 0; n < 2; ++n)
#pragma unroll
                            for (int j = 0; j < 4; ++j) { const int vc = colt - 1024 + bj * 128 + 4 * n + j;
                                VT[((size_t)(b * 8 + (vc >> 6)) * 64 + (vc & 63)) * 2048 + t] = (bf16_t)f2bf(acc[ai][bj][m][n][j]); } }
            return;
        }
#pragma unroll
        for (int ai = 0; ai < 2; ++ai)
#pragma unroll
            for (int m = 0; m < 4; ++m) { bf16_t* rowp = H + (size_t)(row0 + ai * 128 + m * 16) * NIN + colt;
#pragma unroll
                for (int bj = 0; bj < 2; ++bj) { const pg8::f32x4 v0 = acc[ai][bj][m][0], v1 = acc[ai][bj][m][1];
                    u32x4 w; w.x = pk2(v0[0], v0[1]); w.y = pk2(v0[2], v0[3]); w.z = pk2(v1[0], v1[1]); w.w = pk2(v1[2], v1[3]);
                    *(u32x4*)(rowp + bj * 128) = w; } }
        if (u.pn == 2 || u.pn == 3) {
#pragma unroll
            for (int bj = 0; bj < 2; ++bj)
#pragma unroll
                for (int n = 0; n < 2; ++n) { pg8::f32x4 s = acc[0][bj][0][n];
#pragma unroll
                    for (int ai = 0; ai < 2; ++ai)
#pragma unroll
                        for (int m = 0; m < 4; ++m) if (ai + m) s += acc[ai][bj][m][n];
#pragma unroll
                    for (int o = 1; o < 16; o <<= 1) { s[0] += __shfl_xor(s[0], o); s[1] += __shfl_xor(s[1], o); s[2] += __shfl_xor(s[2], o); s[3] += __shfl_xor(s[3], o); }
                    if (fr == 0) *(pg8::f32x4*)(kpart + ((size_t)u.pm * 2 + wr) * 512 + (colt - 512 + bj * 128 + 4 * n)) = s; }
        }
    }
};
struct EpiStore {
    static constexpr bool PERM = true, AFTER_DRAIN = false;
    bf16_t* O; int ldc;
    __device__ __forceinline__ void operator()(const pg8::f32x4 (&acc)[2][2][4][2], const pg8::Unit& u, int wr, int wc, int fr, int fq) const {
        const int row0 = u.pm * 256 + wr * 64 + fr; const int colt = u.pn * 256 + wc * 32 + 8 * fq;
#pragma unroll
        for (int ai = 0; ai < 2; ++ai)
#pragma unroll
            for (int m = 0; m < 4; ++m) { bf16_t* rowp = O + (size_t)(row0 + ai * 128 + m * 16) * ldc + colt;
#pragma unroll
                for (int bj = 0; bj < 2; ++bj) { const pg8::f32x4 v0 = acc[ai][bj][m][0], v1 = acc[ai][bj][m][1];
                    u32x4 w; w.x = pk2(v0[0], v0[1]); w.y = pk2(v0[2], v0[3]); w.z = pk2(v1[0], v1[1]); w.w = pk2(v1[2], v1[3]);
                    *(u32x4*)(rowp + bj * 128) = w; } }
    }
};
__device__ __forceinline__ f32x4 shfl4(f32x4 v, int src) { f32x4 r; r[0] = __shfl(v[0], src); r[1] = __shfl(v[1], src); r[2] = __shfl(v[2], src); r[3] = __shfl(v[3], src); return r; }
__device__ __forceinline__ f32x4 gate4(f32x4 u, f32x4 g) { f32x4 r;
#pragma unroll
    for (int j = 0; j < 4; ++j) { const float e = __builtin_amdgcn_exp2f(-g[j] * LOG2E); r[j] = u[j] * g[j] * __builtin_amdgcn_rcpf(1.f + e); }
    return r; }
struct EpiUp {
    static constexpr bool PERM = true, AFTER_DRAIN = false;
    bf16_t* ACT; float* Z4; const float* cw; const float* cb;
    __device__ __forceinline__ void operator()(const pg8::f32x4 (&acc)[2][2][4][2], const pg8::Unit& u, int wr, int wc, int fr, int fq) const {
        const int src1 = (fq << 4) | ((fr - 1) & 15), src2 = (fq << 4) | ((fr - 2) & 15);
#pragma unroll
        for (int n = 0; n < 2; ++n) {
            const int ch = 128 * u.pn + 32 * wc + 8 * fq + 4 * n; const int tcol = 256 * u.pn + 32 * wc + 8 * fq + 4 * n;
#pragma unroll
            for (int ai = 0; ai < 2; ++ai) {
                const int sb = 4 * u.pm + 2 * ai + wr;
                if (fr < 2) { float* z = Z4 + ((size_t)sb * 4 + fr) * NUP + tcol; *(f32x4*)z = acc[ai][0][0][n]; *(f32x4*)(z + 128) = acc[ai][1][0][n]; }
                if (fr >= 14) { float* z = Z4 + ((size_t)sb * 4 + fr - 12) * NUP + tcol; *(f32x4*)z = acc[ai][0][3][n]; *(f32x4*)(z + 128) = acc[ai][1][3][n]; }
                f32x4 pr1u = {0.f, 0.f, 0.f, 0.f}, pr2u = pr1u, pr1g = pr1u, pr2g = pr1u;
#pragma unroll
                for (int m = 0; m < 4; ++m) {
                    f32x4 sg;
                    { const f32x4 w0 = *(const f32x4*)(cw + DFF + ch), w1 = *(const f32x4*)(cw + NUP + DFF + ch), w2 = *(const f32x4*)(cw + 2 * NUP + DFF + ch), bb = *(const f32x4*)(cb + DFF + ch);
                      const f32x4 zg = acc[ai][1][m][n]; const f32x4 r1 = shfl4(zg, src1), r2 = shfl4(zg, src2);
                      const f32x4 p1 = fr >= 1 ? r1 : pr1g, p2 = fr >= 2 ? r2 : pr2g; pr1g = r1; pr2g = r2;
                      const f32x4 up = bb + w2 * zg + w1 * p1 + w0 * p2;
#pragma unroll
                      for (int j = 0; j < 4; ++j) sg[j] = up[j] * __builtin_amdgcn_rcpf(1.f + __builtin_amdgcn_exp2f(-up[j] * LOG2E)); }
                    asm volatile("" : "+v"(sg));
                    { const f32x4 w0 = *(const f32x4*)(cw + ch), w1 = *(const f32x4*)(cw + NUP + ch), w2 = *(const f32x4*)(cw + 2 * NUP + ch), bb = *(const f32x4*)(cb + ch);
                      const f32x4 zu = acc[ai][0][m][n]; const f32x4 r1 = shfl4(zu, src1), r2 = shfl4(zu, src2);
                      const f32x4 p1 = fr >= 1 ? r1 : pr1u, p2 = fr >= 2 ? r2 : pr2u; pr1u = r1; pr2u = r2;
                      const f32x4 o = (bb + w2 * zu + w1 * p1 + w0 * p2) * sg;
                      if (m > 0 || fr >= 2) { u32x2 w; w.x = pk2(o[0], o[1]); w.y = pk2(o[2], o[3]); *(u32x2*)(ACT + (size_t)(64 * sb + 16 * m + fr) * DFF + ch) = w; } }
                    asm volatile("" ::: "memory");
                }
            }
        }
    }
};
__device__ __forceinline__ void fixup_pass(bf16_t* ACT, const float* Z4, const float* cw, const float* cb, int gtid, int NGT) {
    for (int it = gtid; it < 512 * 704; it += NGT) {
        const int sb = it / 704, ch = 4 * (it % 704); const int tcol = 256 * (ch >> 7) + (ch & 127);
        const float* z = Z4 + (size_t)sb * 4 * NUP + tcol;
        const f32x4 z0u = *(const f32x4*)z, z0g = *(const f32x4*)(z + 128), z1u = *(const f32x4*)(z + NUP), z1g = *(const f32x4*)(z + NUP + 128);
        f32x4 a62u = {0.f, 0.f, 0.f, 0.f}, a62g = a62u, a63u = a62u, a63g = a62u;
        if (sb & 31) { const float* zp = z - 2 * NUP; a62u = *(const f32x4*)zp; a62g = *(const f32x4*)(zp + 128); a63u = *(const f32x4*)(zp + NUP); a63g = *(const f32x4*)(zp + NUP + 128); }
        const f32x4 w0u = *(const f32x4*)(cw + ch), w1u = *(const f32x4*)(cw + NUP + ch), w2u = *(const f32x4*)(cw + 2 * NUP + ch), bu = *(const f32x4*)(cb + ch);
        const f32x4 w0g = *(const f32x4*)(cw + DFF + ch), w1g = *(const f32x4*)(cw + NUP + DFF + ch), w2g = *(const f32x4*)(cw + 2 * NUP + DFF + ch), bg = *(const f32x4*)(cb + DFF + ch);
        const f32x4 o0 = gate4(bu + w2u * z0u + w1u * a63u + w0u * a62u, bg + w2g * z0g + w1g * a63g + w0g * a62g);
        const f32x4 o1 = gate4(bu + w2u * z1u + w1u * z0u + w0u * a63u, bg + w2g * z1g + w1g * z0g + w0g * a63g);
        u32x2 w; w.x = pk2(o0[0], o0[1]); w.y = pk2(o0[2], o0[3]); *(u32x2*)(ACT + (size_t)(64 * sb) * DFF + ch) = w;
        w.x = pk2(o1[0], o1[1]); w.y = pk2(o1[2], o1[3]); *(u32x2*)(ACT + (size_t)(64 * sb + 1) * DFF + ch) = w;
    }
}
__device__ __forceinline__ void unpack8(const u32x4 w, float (&f)[8]) { f[0] = bflo(w.x); f[1] = bfhi(w.x); f[2] = bflo(w.y); f[3] = bfhi(w.y); f[4] = bflo(w.z); f[5] = bfhi(w.z); f[6] = bflo(w.w); f[7] = bfhi(w.w); }
__device__ __forceinline__ u32x4 pack8(const float (&f)[8]) { u32x4 w; w.x = pk2(f[0], f[1]); w.y = pk2(f[2], f[3]); w.z = pk2(f[4], f[5]); w.w = pk2(f[6], f[7]); return w; }
__device__ __forceinline__ void mixer_item(const bf16_t* __restrict__ H, bf16_t* __restrict__ A2, const float* __restrict__ convw, int item, int lane) {
    const int b = item >> 7, t0 = (item & 127) << 4; const size_t rb = (size_t)b * SEQ;
    if (lane < 32) {
        const int c = 8 * lane; float w0[8], w1[8], w2[8], pm2[8], pm1[8];
#pragma unroll
        for (int e = 0; e < 8; ++e) { w0[e] = convw[c + e]; w1[e] = convw[256 + c + e]; w2[e] = convw[512 + c + e]; pm2[e] = 0.f; pm1[e] = 0.f; }
        for (int t = t0 - 2; t < t0 + 16; ++t) {
            float pr[8];
            if (t >= 0) { const bf16_t* hr = H + (rb + t) * NIN; float cc[8], cx[8]; unpack8(*(const u32x4*)(hr + 1792 + c), cc); unpack8(*(const u32x4*)(hr + 2048 + c), cx);
#pragma unroll
                for (int e = 0; e < 8; ++e) pr[e] = cc[e] * cx[e]; }
            else {
#pragma unroll
                for (int e = 0; e < 8; ++e) pr[e] = 0.f; }
            if (t >= t0) { float cbv[8], o[8]; unpack8(*(const u32x4*)(H + (rb + t) * NIN + 1536 + c), cbv);
#pragma unroll
                for (int e = 0; e < 8; ++e) o[e] = cbv[e] * (w0[e] * pm2[e] + w1[e] * pm1[e] + w2[e] * pr[e]);
                *(u32x4*)(A2 + (rb + t) * DM + 512 + c) = pack8(o); }
#pragma unroll
            for (int e = 0; e < 8; ++e) { pm2[e] = pm1[e]; pm1[e] = pr[e]; }
        }
    } else {
        const int c = 8 * (lane - 32), w = 2 << (c >> 6); float S[8];
#pragma unroll
        for (int e = 0; e < 8; ++e) S[e] = 0.f;
        for (int t = t0 - w + 1; t < t0; ++t) if (t >= 0) { float p[8]; unpack8(*(const u32x4*)(H + (rb + t) * NIN + 2304 + c), p);
#pragma unroll
            for (int e = 0; e < 8; ++e) S[e] += p[e]; }
        for (int t = t0; t < t0 + 16; ++t) {
            float p[8], o[8]; unpack8(*(const u32x4*)(H + (rb + t) * NIN + 2304 + c), p);
            const float inv = 1.f / (float)((t + 1) < w ? (t + 1) : w);
#pragma unroll
            for (int e = 0; e < 8; ++e) { S[e] += p[e]; o[e] = S[e] * inv - p[e]; }
            *(u32x4*)(A2 + (rb + t) * DM + 768 + c) = pack8(o);
            if (t - w + 1 >= 0) { float q[8]; unpack8(*(const u32x4*)(H + (rb + t - w + 1) * NIN + 2304 + c), q);
#pragma unroll
                for (int e = 0; e < 8; ++e) S[e] -= q[e]; }
        }
    }
}

constexpr int AL_K = 0, AL_V = 32768, AL_TAB = 32768 + 64 * 528, AL_KM = AL_TAB + 2304 * 4, V_STRIDE = 528;
__device__ __forceinline__ int t5_bucket(int n) {
    if (n < 16) return n;
    return 15 + (n >= 16) + (n >= 21) + (n >= 27) + (n >= 35) + (n >= 46) + (n >= 59) + (n >= 77) + (n >= 99) + (n >= 128) + (n >= 166) + (n >= 216) + (n >= 280) + (n >= 363) + (n >= 470) + (n >= 609) + (n >= 790);
}
template <bool OWN>
__device__ __forceinline__ void attn_block(LAS unsigned char* lds, const bf16x8 (&qr)[4], f32x16 (&o)[2], float& m_run, float& l_run, int distbase, bool selected, int wid, int r32, int hi) {
    if (!OWN) { if (!__any(selected)) return; }
    const LAS unsigned char* Kl = lds + AL_K; const LAS unsigned char* Vl = lds + AL_V; const LAS float* tab = (const LAS float*)(lds + AL_TAB);
    const int pi = (r32 & 19) | ((r32 & 4) << 1) | ((r32 & 8) >> 1);
    const int ql = 32 * wid + r32;
#pragma unroll 1
    for (int t = 0; t < 4; ++t) {
        if (OWN && 64 * t > 32 * wid + 31) break;
        f32x16 p0, p1;
#pragma unroll
        for (int r = 0; r < 16; ++r) { p0[r] = 0.f; p1[r] = 0.f; }
        const int kv0 = 64 * t + pi;
#pragma unroll
        for (int d0 = 0; d0 < 4; ++d0) {
            const int c = 2 * d0 + hi; const int addr = kv0 * 128 + ((c ^ ((kv0 >> 1) & 7)) << 4);
            const bf16x8 a0 = *(const LAS bf16x8*)(Kl + addr), a1 = *(const LAS bf16x8*)(Kl + addr + 32 * 128);
            p0 = __builtin_amdgcn_mfma_f32_32x32x16_bf16(a0, qr[d0], p0, 0, 0, 0);
            p1 = __builtin_amdgcn_mfma_f32_32x32x16_bf16(a1, qr[d0], p1, 0, 0, 0);
        }
        const int dist0 = distbase + ql - 64 * t - 8 * hi;
        const LAS float* tb = tab + 256 + dist0;
        float tmax = NEGBIG;
#pragma unroll
        for (int r = 0; r < 16; ++r) { const int off = (r & 7) + 16 * (r >> 3);
            float s0 = p0[r] * C2 + tb[-off], s1 = p1[r] * C2 + tb[-off - 32];
            if (OWN) { if (dist0 - off < 0) s0 = NEGBIG; if (dist0 - off - 32 < 0) s1 = NEGBIG; }
            else { if (!selected) { s0 = NEGBIG; s1 = NEGBIG; } }
            p0[r] = s0; p1[r] = s1; tmax = fmaxf(tmax, fmaxf(s0, s1)); }
        tmax = fmaxf(tmax, __shfl_xor(tmax, 32));
        const float m_new = fmaxf(m_run, tmax);
        if (__any(m_new > m_run)) { const float al = __builtin_amdgcn_exp2f(m_run - m_new); l_run *= al;
#pragma unroll
            for (int r = 0; r < 16; ++r) { o[0][r] *= al; o[1][r] *= al; } }
        m_run = m_new;
        float ls = 0.f;
#pragma unroll
        for (int r = 0; r < 16; ++r) { p0[r] = __builtin_amdgcn_exp2f(p0[r] - m_new); p1[r] = __builtin_amdgcn_exp2f(p1[r] - m_new); ls += p0[r] + p1[r]; }
        l_run += ls;
        u32x4 pk[4];
        pk[0] = (u32x4){pk2(p0[0], p0[1]), pk2(p0[2], p0[3]), pk2(p0[4], p0[5]), pk2(p0[6], p0[7])};
        pk[1] = (u32x4){pk2(p0[8], p0[9]), pk2(p0[10], p0[11]), pk2(p0[12], p0[13]), pk2(p0[14], p0[15])};
        pk[2] = (u32x4){pk2(p1[0], p1[1]), pk2(p1[2], p1[3]), pk2(p1[4], p1[5]), pk2(p1[6], p1[7])};
        pk[3] = (u32x4){pk2(p1[8], p1[9]), pk2(p1[10], p1[11]), pk2(p1[12], p1[13]), pk2(p1[14], p1[15])};
#pragma unroll
        for (int d0 = 0; d0 < 2; ++d0)
#pragma unroll
            for (int g = 0; g < 4; ++g) { const bf16x8 vf = *(const LAS bf16x8*)(Vl + (32 * d0 + r32) * V_STRIDE + (64 * t + 16 * g + 8 * hi) * 2);
                o[d0] = __builtin_amdgcn_mfma_f32_32x32x16_bf16(vf, __builtin_bit_cast(bf16x8, pk[g]), o[d0], 0, 0, 0); }
    }
}
__device__ __forceinline__ void attn_unit(LAS unsigned char* lds, const bf16_t* __restrict__ H, const bf16_t* __restrict__ VT, const float* __restrict__ kpart, const float* __restrict__ relb,
                                          bf16_t* __restrict__ A2, int b, int h, int i) {
    int tid_ = threadIdx.x; asm volatile("" : "+v"(tid_));
    const int tid = tid_, lane = tid & 63, wid = __builtin_amdgcn_readfirstlane(tid >> 6), r32 = lane & 31, hi = lane >> 5;
    LAS float* tab = (LAS float*)(lds + AL_TAB); LAS float* km = (LAS float*)(lds + AL_KM);
    __syncthreads();
    for (int e = tid; e < 2304; e += NTHREADS) { const int dist = e - 256; tab[e] = relb[h * 32 + t5_bucket(dist < 0 ? 0 : dist)] * LOG2E; }
    if (tid < i * 64) { const int j = tid >> 6, d = tid & 63; const float* kp = kpart + (size_t)((b * 8 + j) * 2) * 512 + h * 64 + d; km[tid] = (kp[0] + kp[512]) * (1.f / 256.f); }
    const size_t rowQ = (size_t)b * SEQ + i * 256 + wid * 32 + r32;
    bf16x8 qr[4];
#pragma unroll
    for (int d0 = 0; d0 < 4; ++d0) qr[d0] = *(const bf16x8*)(H + rowQ * NIN + h * 64 + 16 * d0 + 8 * hi);
#define ATT_LOAD(j) do { _Pragma("unroll") for (int k_ = 0; k_ < 4; ++k_) { const int p_ = tid + 512 * k_; \
        kreg[k_] = *(const u32x4*)(H + ((size_t)b * SEQ + (j) * 256 + (p_ >> 3)) * NIN + 512 + h * 64 + 8 * (p_ & 7)); \
        vreg[k_] = *(const u32x4*)(VT + ((size_t)(b * 8 + h) * 64 + (p_ >> 5)) * SEQ + (j) * 256 + 8 * (p_ & 31)); } } while (0)
#define ATT_STORE() do { _Pragma("unroll") for (int k_ = 0; k_ < 4; ++k_) { const int p_ = tid + 512 * k_; const int kv_ = p_ >> 3, c_ = p_ & 7; \
        *(LAS u32x4*)(lds + AL_K + kv_ * 128 + ((c_ ^ ((kv_ >> 1) & 7)) << 4)) = kreg[k_]; \
        *(LAS u32x4*)(lds + AL_V + (p_ >> 5) * V_STRIDE + 16 * (p_ & 31)) = vreg[k_]; } } while (0)
    { u32x4 kreg[4], vreg[4]; ATT_LOAD(i); ATT_STORE(); }
    __syncthreads();
    unsigned sel;
    {
        float g[7];
#pragma unroll
        for (int j = 0; j < 7; ++j) { float s = 0.f;
            if (j < i) {
#pragma unroll
                for (int d0 = 0; d0 < 4; ++d0)
#pragma unroll
                    for (int e = 0; e < 8; ++e) s += bf2f((unsigned short)qr[d0][e]) * km[j * 64 + 16 * d0 + 8 * hi + e]; }
            g[j] = s + __shfl_xor(s, 32); }
        if (i <= 3) sel = (1u << i) - 1u;
        else { sel = 0u;
#pragma unroll
            for (int s = 0; s < 3; ++s) { float best = -3.0e38f; int bj = 0;
#pragma unroll
                for (int j = 0; j < 7; ++j) { const bool ok = (j < i) && !((sel >> j) & 1u) && (g[j] > best); best = ok ? g[j] : best; bj = ok ? j : bj; }
                sel |= 1u << bj; } }
    }
    f32x16 o[2];
#pragma unroll
    for (int r = 0; r < 16; ++r) { o[0][r] = 0.f; o[1][r] = 0.f; }
    float m_run = NEGBIG, l_run = 0.f;
    attn_block<true>(lds, qr, o, m_run, l_run, 0, true, wid, r32, hi);
#pragma unroll 1
    for (int j = 0; j < i; ++j) {
        __syncthreads();
        { u32x4 kreg[4], vreg[4]; ATT_LOAD(j); ATT_STORE(); }
        __syncthreads();
        attn_block<false>(lds, qr, o, m_run, l_run, (i - j) * 256, ((sel >> j) & 1u) != 0u, wid, r32, hi);
    }
#undef ATT_LOAD
#undef ATT_STORE
    const float inv = 1.f / (l_run + __shfl_xor(l_run, 32));
    bf16_t* orow = A2 + rowQ * DM + h * 64 + 4 * hi;
#pragma unroll
    for (int d0 = 0; d0 < 2; ++d0)
#pragma unroll
        for (int rq = 0; rq < 4; ++rq) { u32x2 w; w.x = pk2(o[d0][4 * rq] * inv, o[d0][4 * rq + 1] * inv); w.y = pk2(o[d0][4 * rq + 2] * inv, o[d0][4 * rq + 3] * inv);
            *(u32x2*)(orow + 32 * d0 + 8 * rq) = w; }
}

constexpr int TBL_OFF = LDS_BYTES - 256;
__device__ __forceinline__ unsigned char* ldp(LAS unsigned char* lds, int idx) {
    const unsigned lo = *(volatile LAS unsigned*)(lds + TBL_OFF + 8 * idx), hi = *(volatile LAS unsigned*)(lds + TBL_OFF + 8 * idx + 4);
    return (unsigned char*)(((unsigned long long)(unsigned)__builtin_amdgcn_readfirstlane((int)hi) << 32) | (unsigned long long)(unsigned)__builtin_amdgcn_readfirstlane((int)lo));
}
__global__ void __launch_bounds__(NTHREADS, 2) hymba_fwd(Args a) {
    extern __shared__ __attribute__((aligned(16))) unsigned char lds_raw[];
    LAS unsigned char* lds = (LAS unsigned char*)lds_raw;
    cg::grid_group grid = cg::this_grid();
    const int tid = threadIdx.x, lane = tid & 63, wave = __builtin_amdgcn_readfirstlane(tid >> 6);
    const int G = gridDim.x, bx = blockIdx.x;
    const int gw = bx * NWAVES + wave, NGW = G * NWAVES;
    if (tid == 0) { LAS unsigned long long* T = (LAS unsigned long long*)(lds + TBL_OFF);
        T[0] = (unsigned long long)a.x; T[1] = (unsigned long long)a.w_in; T[2] = (unsigned long long)a.conv_w; T[3] = (unsigned long long)a.w_pool; T[4] = (unsigned long long)a.pool_scale;
        T[5] = (unsigned long long)a.w_out; T[6] = (unsigned long long)a.ln1_g; T[7] = (unsigned long long)a.ln1_b; T[8] = (unsigned long long)a.w_up; T[9] = (unsigned long long)a.ffn_conv_w;
        T[10] = (unsigned long long)a.ffn_conv_b; T[11] = (unsigned long long)a.w_down; T[12] = (unsigned long long)a.ln2_g; T[13] = (unsigned long long)a.ln2_b; T[14] = (unsigned long long)a.rel_bias;
        T[15] = (unsigned long long)a.out; T[16] = (unsigned long long)a.ws; }
    prologue(a, lds, gw, NGW, wave, lane);
    __syncthreads();
    grid.sync();

#pragma unroll 1
    for (int l = 0; l < DEPTH; ++l) {
        int tid = threadIdx.x; asm volatile("" : "+v"(tid)); const int lane = tid & 63;
#ifndef SKIP_P1
        { unsigned char* ws = ldp(lds, 16);
          pg8::Gemm g{(const bf16_t*)(ws + WS_XB), (const bf16_t*)(ws + WS_WIN) + (size_t)l * WIN_L, MTOK, NIN, DM}; pg8::StaticOrder S; S.init(MTOK, NIN, G, bx);
          EpiH E{(bf16_t*)(ws + WS_H), (bf16_t*)(ws + WS_VT), (float*)(ws + WS_KP)};
          pg8::gemm_phase<EpiH, pg8::StaticOrder, true, true>(lds, g, S, E); }
#endif
        grid.sync();
#ifndef SKIP_P2
        { unsigned char* ws = ldp(lds, 16); const bf16_t* H = (const bf16_t*)(ws + WS_H); bf16_t* A2 = (bf16_t*)(ws + WS_A2);
          { const float* cw = (const float*)ldp(lds, 2) + (size_t)l * 768;
            for (int it = gw; it < BATCH * 128; it += NGW) mixer_item(H, A2, cw, it, lane); }
          const bf16_t* VT = (const bf16_t*)(ws + WS_VT); const float* KP = (const float*)(ws + WS_KP); const float* relb = (const float*)ldp(lds, 14);
#pragma unroll 1
          for (int p = 2 * bx; p < 1024; p += 2 * G) {
#pragma unroll 1
              for (int uu = 0; uu < 2; ++uu) { const int bh = p >> 3, s = (p >> 1) & 3;
                  attn_unit(lds, H, VT, KP, relb, A2, bh >> 3, bh & 7, uu ? s : 7 - s); } }
          __syncthreads(); }
#endif
        grid.sync();
#ifndef SKIP_P3
        { unsigned char* ws = ldp(lds, 16);
          pg8::Gemm g{(const bf16_t*)(ws + WS_A2), (const bf16_t*)(ws + WS_WOUT) + (size_t)l * WOUT_L, MTOK, DM, DM}; pg8::StaticOrder S; S.init(MTOK, DM, G, bx);
          EpiStore E{(bf16_t*)(ws + WS_MIX), DM};
          pg8::gemm_phase<EpiStore, pg8::StaticOrder, true, true>(lds, g, S, E); }
#endif
        grid.sync();
        { unsigned char* ws = ldp(lds, 16); float* out = (float*)ldp(lds, 15); const float* xin = l == 0 ? (const float*)ldp(lds, 0) : out;
          ln_pass(xin, (const bf16_t*)(ws + WS_MIX), out, (const float*)ldp(lds, 6) + l * DM, (const float*)ldp(lds, 7) + l * DM, (bf16_t*)(ws + WS_XB), gw, NGW, lane); }
        grid.sync();
#ifndef SKIP_P5
        { unsigned char* ws = ldp(lds, 16);
          pg8::Gemm g{(const bf16_t*)(ws + WS_XB), (const bf16_t*)(ws + WS_WUP) + (size_t)l * WUP_L, MTOK, NUP, DM}; pg8::StaticOrder S; S.init(MTOK, NUP, G, bx);
          EpiUp E{(bf16_t*)(ws + WS_ACT), (float*)(ws + WS_Z4), (const float*)ldp(lds, 9) + (size_t)l * 3 * NUP, (const float*)ldp(lds, 10) + (size_t)l * NUP};
          pg8::gemm_phase<EpiUp, pg8::StaticOrder, true, true>(lds, g, S, E); }
#endif
        grid.sync();
        { unsigned char* ws = ldp(lds, 16);
          fixup_pass((bf16_t*)(ws + WS_ACT), (const float*)(ws + WS_Z4), (const float*)ldp(lds, 9) + (size_t)l * 3 * NUP, (const float*)ldp(lds, 10) + (size_t)l * NUP, bx * NTHREADS + tid, G * NTHREADS); }
        grid.sync();
#ifndef SKIP_P7
        { unsigned char* ws = ldp(lds, 16);
          pg8::Gemm g{(const bf16_t*)(ws + WS_ACT), (const bf16_t*)(ws + WS_WDN) + (size_t)l * WDN_L, MTOK, DM, DFF}; pg8::StaticOrder S; S.init(MTOK, DM, G, bx);
          EpiStore E{(bf16_t*)(ws + WS_MIX), DM};
          pg8::gemm_phase<EpiStore, pg8::StaticOrder, true, true>(lds, g, S, E); }
#endif
        grid.sync();
        { unsigned char* ws = ldp(lds, 16); float* out = (float*)ldp(lds, 15);
          ln_pass(out, (const bf16_t*)(ws + WS_MIX), out, (const float*)ldp(lds, 12) + l * DM, (const float*)ldp(lds, 13) + l * DM, (bf16_t*)(ws + WS_XB), gw, NGW, lane); }
        if (l + 1 < DEPTH) grid.sync();
    }
}

extern "C" void kernel_launch(void* const* d_in, const int* in_sizes, int n_in, void* d_out, int out_size, void* d_ws, size_t ws_size, hipStream_t stream) {
    static int grid = 0;
    if (grid == 0) {
        if (n_in != 15 || in_sizes[0] != MTOK * DM || out_size != MTOK * DM || ws_size < WS_END) { fprintf(stderr, "kernel_launch: unexpected shapes (n_in %d, ws %zu)\n", n_in, ws_size); grid = -1; return; }
        int dev = 0, cus = 0, per_cu = 0;
        hipGetDevice(&dev); hipDeviceGetAttribute(&cus, hipDeviceAttributeMultiprocessorCount, dev);
        if (hipFuncSetAttribute((const void*)hymba_fwd, hipFuncAttributeMaxDynamicSharedMemorySize, LDS_BYTES) != hipSuccess) { fprintf(stderr, "kernel_launch: hipFuncSetAttribute failed\n"); grid = -1; return; }
        if (hipOccupancyMaxActiveBlocksPerMultiprocessor(&per_cu, (const void*)hymba_fwd, NTHREADS, LDS_BYTES) != hipSuccess || per_cu < 1) { fprintf(stderr, "kernel_launch: occupancy query says %d\n", per_cu); per_cu = 1; }
        (void)hipGetLastError();
        grid = cus;
    }
    if (grid < 0) return;
    Args a{};
    const float** f = (const float**)&a;
    for (int i = 0; i < 15; ++i) f[i] = (const float*)d_in[i];
    a.out = (float*)d_out; a.ws = (unsigned char*)d_ws;
    void* args[] = {&a};
    hipError_t e = hipLaunchCooperativeKernel((const void*)hymba_fwd, dim3(grid), dim3(NTHREADS), args, LDS_BYTES, stream);
    if (e != hipSuccess) fprintf(stderr, "kernel_launch: cooperative launch failed: %s (grid %d)\n", hipGetErrorString(e), grid);
}
```

```cpp
#include <hip/hip_runtime.h>
#include <hip/hip_cooperative_groups.h>
#include <cstdio>
#include <cstdint>
namespace cg = cooperative_groups;
#ifndef REP_P2
#define REP_P2 1
#endif
#ifndef REP_SYNC
#define REP_SYNC 1
#endif
#define GRID_SYNC() do { for (int rs_ = 0; rs_ < REP_SYNC; ++rs_) xcd_barrier(xbar); } while (0)
namespace pg8 {
#define PG8_LAS __attribute__((address_space(3)))
typedef unsigned short bf16_t;
typedef short bf16x8 __attribute__((ext_vector_type(8)));
typedef float f32x4 __attribute__((ext_vector_type(4)));
typedef unsigned u32x4 __attribute__((ext_vector_type(4)));
constexpr int BM = 256, BK = 64, HALF = 128, HTB = HALF * BK * 2  , STAGE_BYTES = 8 * HTB, NXCD = 8, WGM = 8;

__host__ __device__ __forceinline__ int lds_byte(int r, int c) { const int st = (r >> 4) * 2 + (c >> 5), rr = r & 15, cc = c & 31, ob = rr * 64 + cc * 2; return st * 1024 + (ob ^ (((ob >> 9) & 1) << 5)); }
__host__ __device__ __forceinline__ void stage_rc(int b, int& R, int& C) { const int st = b / 1024, sb = b % 1024, swz = sb ^ (((sb >> 9) & 1) << 5); R = (st >> 1) * 16 + swz / 64; C = (st & 1) * 32 + (swz % 64) / 2; }
__host__ __device__ __forceinline__ int perm32(int rho) { const int n = rho >> 4, i = rho & 15; return 8 * (i >> 2) + 4 * n + (i & 3); }

struct Unit { int pm, pn; };
struct Gemm { const bf16_t* A; const bf16_t* Bt; int M, N, K; };

struct StaticOrder {
    int nM, nN, nwg, G, c;
    __host__ __device__ void init(int M, int N, int G_, int c_) { nM = M / BM; nN = N / BM; nwg = nM * nN; G = G_; c = c_; }
    __host__ __device__ bool next(int i, Unit& u) const {
        const long L = (long)i * G + c; if (L >= nwg) return false;
        int wgid = (int)L; { const int q = nwg / NXCD, r = nwg % NXCD, xcd = wgid % NXCD, off = wgid / NXCD; wgid = (xcd < r ? xcd * (q + 1) : r * (q + 1) + (xcd - r) * q) + off; }
        const int nig = WGM * nN, gid = wgid / nig, fm = gid * WGM, gsz = (nM - fm) < WGM ? (nM - fm) : WGM;
        u.pm = fm + ((wgid % nig) % gsz); u.pn = (wgid % nig) / gsz; return true;
    }
    __device__ __forceinline__ void a_ready(const Unit&) const {}
    __device__ __forceinline__ void done(const Unit&) const {}
};

__device__ __forceinline__ unsigned cvt_pk_bf16(float lo, float hi) { unsigned r; asm volatile("v_cvt_pk_bf16_f32 %0, %1, %2" : "=v"(r) : "v"(lo), "v"(hi)); return r; }
typedef float f32x2 __attribute__((ext_vector_type(2)));
template <class Epi, class Sched, bool ALIGN_EPI = false, bool SP2 = false>
__device__ __forceinline__ void gemm_phase(PG8_LAS unsigned char* lds, const Gemm g, const Sched& S, const Epi& E) {
    int tid_ = threadIdx.x; asm volatile("" : "+v"(tid_));
    const int tid = tid_, wid = __builtin_amdgcn_readfirstlane(tid >> 6), lane = tid & 63, wr = wid >> 2, wc = wid & 3, fr = lane & 15, fq = lane >> 4;
    const int K = g.K, nt = K / BK;
    unsigned voffA[2], voffB[2];
#pragma unroll
    for (int i = 0; i < 2; ++i) { int R, C; stage_rc(tid * 16 + i * 8192, R, C); const int Rb = Epi::PERM ? ((R & ~31) + perm32(R & 31)) : R;
        voffA[i] = (unsigned)(R * K + C) * 2u; voffB[i] = (unsigned)(Rb * K + C) * 2u; }
    const size_t kstep = (size_t)(BK * 2);
    const size_t hstep = (size_t)HALF * K * 2;
    const size_t tstep = 2 * hstep;
    const unsigned ldsw = (unsigned)wid * 1024u;
    const int aoff = lds_byte(wr * 64 + fr, fq * 8), boff = lds_byte(wc * 32 + fr, fq * 8);
#define PG8_SA(b, h) (((b) * 2 + (h)) * HTB)
#define PG8_SB(b, h) ((4 + (b) * 2 + (h)) * HTB)
#define PG8_STAGE(bufoff, gbase, voff) do { _Pragma("unroll") for (int _i = 0; _i < 2; ++_i) \
        __builtin_amdgcn_global_load_lds((const unsigned*)((const char*)(gbase) + (voff)[_i]), (PG8_LAS unsigned*)(lds + (bufoff) + ldsw + _i * 8192), 16, 0, 0); } while (0)
#define PG8_LDA(dst, b, h) do { _Pragma("unroll") for (int m = 0; m < 4; ++m) _Pragma("unroll") for (int k = 0; k < 2; ++k) dst[m][k] = *(const PG8_LAS bf16x8*)(lds + PG8_SA(b, h) + aoff + m * 2048 + k * 1024); } while (0)
#define PG8_LDB(dst, b, h) do { _Pragma("unroll") for (int n = 0; n < 2; ++n) _Pragma("unroll") for (int k = 0; k < 2; ++k) dst[n][k] = *(const PG8_LAS bf16x8*)(lds + PG8_SB(b, h) + boff + n * 2048 + k * 1024); } while (0)
#define PG8_MMA(ai, bj, At, Bt) do { __builtin_amdgcn_s_setprio(1); _Pragma("unroll") for (int m = 0; m < 4; ++m) _Pragma("unroll") for (int n = 0; n < 2; ++n) _Pragma("unroll") for (int k = 0; k < 2; ++k) \
        acc[ai][bj][m][n] = __builtin_amdgcn_mfma_f32_16x16x32_bf16(Bt[n][k], At[m][k], acc[ai][bj][m][n], 0, 0, 0); __builtin_amdgcn_s_setprio(0); } while (0)
#define PG8_WAIT_V(n) asm volatile("s_waitcnt vmcnt(" #n ")" ::: "memory")
#define PG8_WAIT_L(n) asm volatile("s_waitcnt lgkmcnt(" #n ")" ::: "memory")
#define PG8_BAR __builtin_amdgcn_s_barrier()
#define PG8_SCHED __builtin_amdgcn_sched_barrier(0)
    Unit cur, nxt; int ui = 0;
    if (!S.next(0, cur)) return;
    f32x4 acc[2][2][4][2];
#pragma unroll
    for (int a = 0; a < 2; ++a)
#pragma unroll
        for (int b = 0; b < 2; ++b)
#pragma unroll
            for (int m = 0; m < 4; ++m)
#pragma unroll
                for (int n = 0; n < 2; ++n) acc[a][b][m][n] = (f32x4){0.f, 0.f, 0.f, 0.f};
    bf16x8 At[4][2], B0[2][2], B1[2][2];
    const char* cA = (const char*)g.A + (size_t)cur.pm * tstep; const char* cB = (const char*)g.Bt + (size_t)cur.pn * tstep;
    S.a_ready(cur);
    if constexpr (SP2) {
        PG8_STAGE(PG8_SB(0, 0), cB, voffB); PG8_STAGE(PG8_SB(0, 1), cB + hstep, voffB); PG8_STAGE(PG8_SA(0, 0), cA, voffA); PG8_STAGE(PG8_SA(0, 1), cA + hstep, voffA);
        if (wr == 1) PG8_BAR;
        PG8_WAIT_V(2); PG8_BAR;
        PG8_STAGE(PG8_SB(1, 0), cB + kstep, voffB); PG8_STAGE(PG8_SA(1, 0), cA + kstep, voffA); PG8_STAGE(PG8_SB(1, 1), cB + hstep + kstep, voffB);
        PG8_WAIT_V(6); PG8_BAR;
    } else {
        PG8_STAGE(PG8_SB(0, 0), cB, voffB); PG8_STAGE(PG8_SA(0, 0), cA, voffA); PG8_STAGE(PG8_SB(0, 1), cB + hstep, voffB); PG8_STAGE(PG8_SA(0, 1), cA + hstep, voffA);
        if (wr == 1) PG8_BAR;
        PG8_WAIT_V(4); PG8_BAR;
        PG8_STAGE(PG8_SB(1, 0), cB + kstep, voffB); PG8_STAGE(PG8_SA(1, 0), cA + kstep, voffA); PG8_STAGE(PG8_SB(1, 1), cB + hstep + kstep, voffB);
        PG8_WAIT_V(6); PG8_BAR;
    }
    for (;;) {
        const bool has_next = S.next(ui + 1, nxt);
        const char* nA = has_next ? (const char*)g.A + (size_t)nxt.pm * tstep : cA; const char* nB = has_next ? (const char*)g.Bt + (size_t)nxt.pn * tstep : cB;
        for (int t = 0; t < nt; t += 2) {
            const bool last = (t == nt - 2);
            const char* a1 = cA + (size_t)(t + 1) * kstep;
            const char* a2 = last ? nA : cA + (size_t)(t + 2) * kstep; const char* b2 = last ? nB : cB + (size_t)(t + 2) * kstep;
            const char* a3 = a2 + kstep; const char* b3 = b2 + kstep;
            if (last && has_next) S.a_ready(nxt);
            if constexpr (SP2) {
            PG8_LDB(B0, 0, 0); PG8_LDB(B1, 0, 1); PG8_SCHED; PG8_LDA(At, 0, 0); PG8_STAGE(PG8_SA(1, 1), a1 + hstep, voffA);
            PG8_WAIT_V(8); PG8_WAIT_L(0); PG8_BAR; PG8_MMA(0, 0, At, B0); PG8_MMA(0, 1, At, B1); PG8_BAR; PG8_SCHED;
            PG8_LDA(At, 0, 1); PG8_STAGE(PG8_SB(0, 0), b2, voffB); PG8_STAGE(PG8_SB(0, 1), b2 + hstep, voffB); PG8_STAGE(PG8_SA(0, 0), a2, voffA);
            PG8_WAIT_V(8); PG8_WAIT_L(0); PG8_BAR; PG8_MMA(1, 0, At, B0); PG8_MMA(1, 1, At, B1); PG8_BAR; PG8_SCHED;
            PG8_LDB(B0, 1, 0); PG8_LDB(B1, 1, 1); PG8_SCHED; PG8_LDA(At, 1, 0); PG8_STAGE(PG8_SA(0, 1), a2 + hstep, voffA);
            PG8_WAIT_V(8); PG8_WAIT_L(0); PG8_BAR; PG8_MMA(0, 0, At, B0); PG8_MMA(0, 1, At, B1); PG8_BAR; PG8_SCHED;
            PG8_LDA(At, 1, 1); PG8_STAGE(PG8_SB(1, 0), b3, voffB); PG8_STAGE(PG8_SB(1, 1), b3 + hstep, voffB); PG8_STAGE(PG8_SA(1, 0), a3, voffA);
            PG8_WAIT_V(8); PG8_WAIT_L(0); PG8_BAR; PG8_MMA(1, 0, At, B0); PG8_MMA(1, 1, At, B1); PG8_BAR; PG8_SCHED;
            } else {
            PG8_LDB(B0, 0, 0); PG8_SCHED; PG8_LDA(At, 0, 0); PG8_STAGE(PG8_SA(1, 1), a1 + hstep, voffA);
            PG8_WAIT_L(8); PG8_BAR; PG8_WAIT_L(0); PG8_MMA(0, 0, At, B0); PG8_BAR; PG8_SCHED;
            PG8_LDB(B1, 0, 1); PG8_STAGE(PG8_SB(0, 0), b2, voffB);
            PG8_BAR; PG8_WAIT_L(0); PG8_MMA(0, 1, At, B1); PG8_BAR;
            PG8_LDA(At, 0, 1); PG8_STAGE(PG8_SA(0, 0), a2, voffA);
            PG8_BAR; PG8_WAIT_L(0); PG8_MMA(1, 0, At, B0); PG8_BAR; PG8_SCHED;
            PG8_STAGE(PG8_SB(0, 1), b2 + hstep, voffB);
            PG8_WAIT_V(6); PG8_BAR; PG8_MMA(1, 1, At, B1); PG8_BAR;
            PG8_LDB(B0, 1, 0); PG8_SCHED; PG8_LDA(At, 1, 0); PG8_STAGE(PG8_SA(0, 1), a2 + hstep, voffA);
            PG8_WAIT_L(8); PG8_BAR; PG8_WAIT_L(0); PG8_MMA(0, 0, At, B0); PG8_BAR; PG8_SCHED;
            PG8_LDB(B1, 1, 1); PG8_STAGE(PG8_SB(1, 0), b3, voffB);
            PG8_BAR; PG8_WAIT_L(0); PG8_MMA(0, 1, At, B1); PG8_BAR;
            PG8_LDA(At, 1, 1); PG8_STAGE(PG8_SA(1, 0), a3, voffA);
            PG8_BAR; PG8_WAIT_L(0); PG8_MMA(1, 0, At, B0); PG8_BAR; PG8_SCHED;
            PG8_STAGE(PG8_SB(1, 1), b3 + hstep, voffB);
            PG8_WAIT_V(6); PG8_BAR; PG8_MMA(1, 1, At, B1); PG8_BAR;
            }
        }
        if constexpr (ALIGN_EPI) { if (wr == 0) PG8_BAR; }
        if constexpr (!Epi::AFTER_DRAIN) { E(acc, cur, wr, wc, fr, fq); S.done(cur); }
        if (!has_next) break;
#pragma unroll
        for (int a = 0; a < 2; ++a)
#pragma unroll
            for (int b = 0; b < 2; ++b)
#pragma unroll
                for (int m = 0; m < 4; ++m)
#pragma unroll
                    for (int n = 0; n < 2; ++n) acc[a][b][m][n] = (f32x4){0.f, 0.f, 0.f, 0.f};
        cur = nxt; cA = nA; cB = nB; ++ui;
        if constexpr (ALIGN_EPI) { if (wr == 1) PG8_BAR; }
    }
    PG8_WAIT_V(0);
    if constexpr (!ALIGN_EPI) { if (wr == 0) PG8_BAR; }
    PG8_BAR;
    if constexpr (Epi::AFTER_DRAIN) { E.fused(acc, cur, wr, wc, fr, fq, lds, wid, lane); S.done(cur); }
#undef PG8_SA
#undef PG8_SB
#undef PG8_STAGE
#undef PG8_LDA
#undef PG8_LDB
#undef PG8_MMA
#undef PG8_WAIT_V
#undef PG8_WAIT_L
#undef PG8_BAR
#undef PG8_SCHED
}
}
#define LAS __attribute__((address_space(3)))
typedef unsigned short bf16_t;
typedef short bf16x8 __attribute__((ext_vector_type(8)));
typedef float f32x4 __attribute__((ext_vector_type(4)));
typedef float f32x16 __attribute__((ext_vector_type(16)));
typedef unsigned u32x4 __attribute__((ext_vector_type(4)));
typedef unsigned u32x2 __attribute__((ext_vector_type(2)));

constexpr int BATCH = 16, SEQ = 2048, DM = 1024, DEPTH = 4, MTOK = BATCH * SEQ;
constexpr int NIN = 2560, DFF = 2816, NUP = 5632;
constexpr float ALPHA = 1.6817928305074292f;
constexpr float LN_EPS = 1e-5f;
constexpr float LOG2E = 1.4426950408889634f;
constexpr float C2 = 0.125f * 1.4426950408889634f;
constexpr float NEGBIG = -1e30f;
constexpr int NWAVES = 8, NTHREADS = 512;
constexpr int LDS_BYTES = 160 * 1024;

constexpr size_t MiB = 1u << 20;
constexpr size_t WS_WIN = 0, WS_WOUT = 20 * MiB, WS_WUP = 28 * MiB, WS_WDN = 72 * MiB, WS_XB = 96 * MiB, WS_H = 160 * MiB, WS_A2 = 320 * MiB,
                 WS_ACT = 160 * MiB, WS_VT = 384 * MiB, WS_Z4 = 416 * MiB, WS_KP = 460 * MiB, WS_MIX = 384 * MiB  , WS_BAR = 461 * MiB, WS_END = 462 * MiB;
constexpr size_t WIN_L = (size_t)NIN * DM, WOUT_L = (size_t)DM * DM, WUP_L = (size_t)NUP * DM, WDN_L = (size_t)DM * DFF;

struct Args {
    const float *x, *w_in, *conv_w, *w_pool, *pool_scale, *w_out, *ln1_g, *ln1_b, *w_up, *ffn_conv_w, *ffn_conv_b, *w_down, *ln2_g, *ln2_b, *rel_bias;
    float* out; unsigned char* ws;
};

__device__ __forceinline__ unsigned f2bf(float f) { unsigned u = __builtin_bit_cast(unsigned, f); return (u + 0x7fffu + ((u >> 16) & 1u)) >> 16; }
__device__ __forceinline__ unsigned pk2(float lo, float hi) { return pg8::cvt_pk_bf16(lo, hi); }
__device__ __forceinline__ float bf2f(unsigned short s) { return __uint_as_float(((unsigned)s) << 16); }
__device__ __forceinline__ float bflo(unsigned w) { return __uint_as_float(w << 16); }
__device__ __forceinline__ float bfhi(unsigned w) { return __uint_as_float(w & 0xffff0000u); }
__device__ __forceinline__ float wave_sum(float v) {
#pragma unroll
    for (int o = 1; o < 64; o <<= 1) v += __shfl_xor(v, o);
    return v;
}

__device__ __forceinline__ void transpose_item(const float* W, int K, int N, bf16_t* WT, int k0, int n0, int row0, LAS float* scr, int lane) {
#pragma unroll 8
    for (int i = 0; i < 32; ++i) { const int kk = 2 * i + (lane >> 5); scr[kk * 33 + (lane & 31)] = W[(size_t)(k0 + kk) * N + n0 + (lane & 31)]; }
    asm volatile("s_waitcnt lgkmcnt(0)" ::: "memory");
    const int c = lane & 7;
#pragma unroll
    for (int j = 0; j < 4; ++j) { const int n = (lane >> 3) + 8 * j; const LAS float* s = scr + (8 * c) * 33 + n;
        u32x4 o; o.x = pk2(s[0 * 33], s[1 * 33]); o.y = pk2(s[2 * 33], s[3 * 33]); o.z = pk2(s[4 * 33], s[5 * 33]); o.w = pk2(s[6 * 33], s[7 * 33]);
        *(u32x4*)(WT + (size_t)(row0 + n) * K + k0 + 8 * c) = o; }
    asm volatile("s_waitcnt lgkmcnt(0)" ::: "memory");
}
__device__ __forceinline__ int up_row(int n0) { int ch = n0 < DFF ? n0 : n0 - DFF; return 256 * (ch >> 7) + (ch & 127) + (n0 < DFF ? 0 : 128); }

__device__ __forceinline__ void prologue(const Args& a, LAS unsigned char* lds, int gw, int NGW, int wave, int lane) {
    LAS float* scr = (LAS float*)(lds + wave * 16384);
    bf16_t* WinT = (bf16_t*)(a.ws + WS_WIN); bf16_t* WoutT = (bf16_t*)(a.ws + WS_WOUT); bf16_t* WupT = (bf16_t*)(a.ws + WS_WUP); bf16_t* WdnT = (bf16_t*)(a.ws + WS_WDN);
    constexpr int I_IN = 16 * 80, I_OUT = 12 * 32, I_UP = 16 * 176, I_DN = 44 * 32, I_L = I_IN + I_OUT + I_UP + I_DN;
    for (int it = gw; it < DEPTH * I_L; it += NGW) {
        const int l = it / I_L; int r = it % I_L;
        if (r < I_IN) { const int kb = r / 80, nb = r % 80; transpose_item(a.w_in + (size_t)l * WIN_L, DM, NIN, WinT + (size_t)l * WIN_L, 64 * kb, 32 * nb, 32 * nb, scr, lane); continue; } r -= I_IN;
        if (r < I_OUT) { const int kb = r / 32, nb = r % 32; transpose_item(a.w_out + (size_t)l * WOUT_L, DM, DM, WoutT + (size_t)l * WOUT_L, 64 * kb, 32 * nb, 32 * nb, scr, lane); continue; } r -= I_OUT;
        if (r < I_UP) { const int kb = r / 176, nb = r % 176; transpose_item(a.w_up + (size_t)l * WUP_L, DM, NUP, WupT + (size_t)l * WUP_L, 64 * kb, 32 * nb, up_row(32 * nb), scr, lane); continue; } r -= I_UP;
        { const int kb = r / 32, nb = r % 32; transpose_item(a.w_down + (size_t)l * WDN_L, DFF, DM, WdnT + (size_t)l * WDN_L, 64 * kb, 32 * nb, 32 * nb, scr, lane); }
    }
    for (int it = gw; it < DEPTH * 256 * 16; it += NGW) {
        const int l = it >> 12, gc = (it >> 4) & 255, n = ((it & 15) << 6) + lane, g = gc >> 6;
        const float* wp = a.w_pool + ((size_t)l * 256 + gc) * 64; const float* ps = a.pool_scale + l * 256 + 64 * g;
        const float* wo = a.w_out + (size_t)l * WOUT_L + (size_t)(768 + 64 * g) * DM + n;
        float acc = 0.f;
#pragma unroll 8
        for (int d = 0; d < 64; ++d) acc += wp[d] * ps[d] * wo[(size_t)d * DM];
        WoutT[(size_t)l * WOUT_L + (size_t)n * DM + 768 + gc] = (bf16_t)f2bf(acc);
    }
    bf16_t* XB = (bf16_t*)(a.ws + WS_XB);
    for (int m = gw; m < MTOK; m += NGW) {
        const f32x4* xr = (const f32x4*)(a.x + (size_t)m * DM) + lane; u32x2* o = (u32x2*)(XB + (size_t)m * DM) + lane;
#pragma unroll
        for (int j = 0; j < 4; ++j) { const f32x4 v = xr[64 * j]; u32x2 w; w.x = pk2(v.x, v.y); w.y = pk2(v.z, v.w); o[64 * j] = w; }
    }
}

__device__ __forceinline__ void ln_pass(const float* X, const bf16_t* MIX, float* Y, const float* g, const float* b, bf16_t* XB, int gw, int NGW, int lane) {
    f32x4 gv[4], bv[4];
#pragma unroll
    for (int j = 0; j < 4; ++j) { gv[j] = ((const f32x4*)g)[lane + 64 * j]; bv[j] = ((const f32x4*)b)[lane + 64 * j]; }
    for (int m = gw; m < MTOK; m += NGW) {
        const f32x4* xr = (const f32x4*)(X + (size_t)m * DM) + lane; const u32x2* mr = (const u32x2*)(MIX + (size_t)m * DM) + lane;
        f32x4* yr = (f32x4*)(Y + (size_t)m * DM) + lane; u32x2* o = (u32x2*)(XB + (size_t)m * DM) + lane;
        f32x4 v[4]; float s = 0.f;
#pragma unroll
        for (int j = 0; j < 4; ++j) { const f32x4 xv = xr[64 * j]; const u32x2 mw = mr[64 * j];
            v[j] = xv * ALPHA + (f32x4){bflo(mw.x), bfhi(mw.x), bflo(mw.y), bfhi(mw.y)}; s += (v[j].x + v[j].y) + (v[j].z + v[j].w); }
        const float mean = wave_sum(s) * (1.f / DM); float s2 = 0.f;
#pragma unroll
        for (int j = 0; j < 4; ++j) { v[j] = v[j] - mean; s2 += (v[j].x * v[j].x + v[j].y * v[j].y) + (v[j].z * v[j].z + v[j].w * v[j].w); }
        const float rstd = 1.f / sqrtf(wave_sum(s2) * (1.f / DM) + LN_EPS);
#pragma unroll
        for (int j = 0; j < 4; ++j) { const f32x4 r = v[j] * rstd * gv[j] + bv[j]; yr[64 * j] = r; u32x2 w; w.x = pk2(r.x, r.y); w.y = pk2(r.z, r.w); o[64 * j] = w; }
    }
}

struct EpiH {
    static constexpr bool PERM = true, AFTER_DRAIN = false;
    bf16_t* H; bf16_t* VT; float* kpart;
    __device__ __forceinline__ void operator()(const pg8::f32x4 (&acc)[2][2][4][2], const pg8::Unit& u, int wr, int wc, int fr, int fq) const {
        const int row0 = u.pm * 256 + wr * 64 + fr; const int colt = u.pn * 256 + wc * 32 + 8 * fq;
        if (u.pn == 4 || u.pn == 5) {
#pragma unroll
            for (int ai = 0; ai < 2; ++ai)
#pragma unroll
                for (int m = 0; m < 4; ++m) { const int row = row0 + ai * 128 + m * 16; const int b = row >> 11, t = row & 2047;
#pragma unroll
                    for (int bj = 0; bj < 2; ++bj)
#pragma unroll
                        for (int n = 0; n < 2; ++n)
#pragma unroll
                            for (int j = 0; j < 4; ++j) { const int vc = colt - 1024 + bj * 128 + 4 * n + j;
                                VT[((size_t)(b * 8 + (vc >> 6)) * 64 + (vc & 63)) * 2048 + t] = (bf16_t)f2bf(acc[ai][bj][m][n][j]); } }
            return;
        }
#pragma unroll
        for (int ai = 0; ai < 2; ++ai)
#pragma unroll
            for (int m = 0; m < 4; ++m) { bf16_t* rowp = H + (size_t)(row0 + ai * 128 + m * 16) * NIN + colt;
#pragma unroll
                for (int bj = 0; bj < 2; ++bj) { const pg8::f32x4 v0 = acc[ai][bj][m][0], v1 = acc[ai][bj][m][1];
                    u32x4 w; w.x = pk2(v0[0], v0[1]); w.y = pk2(v0[2], v0[3]); w.z = pk2(v1[0], v1[1]); w.w = pk2(v1[2], v1[3]);
                    *(u32x4*)(rowp + bj * 128) = w; } }
        if (u.pn == 2 || u.pn == 3) {
#pragma unroll
            for (int bj = 0; bj < 2; ++bj)
#pragma unroll
                for (int n = 0; n < 2; ++n) { pg8::f32x4 s = acc[0][bj][0][n];
#pragma unroll
                    for (int ai = 0; ai < 2; ++ai)
#pragma unroll
                        for (int m = 0; m < 4; ++m) if (ai + m) s += acc[ai][bj][m][n];
#pragma unroll
                    for (int o = 1; o < 16; o <<= 1) { s[0] += __shfl_xor(s[0], o); s[1] += __shfl_xor(s[1], o); s[2] += __shfl_xor(s[2], o); s[3] += __shfl_xor(s[3], o); }
                    if (fr == 0) *(pg8::f32x4*)(kpart + ((size_t)u.pm * 2 + wr) * 512 + (colt - 512 + bj * 128 + 4 * n)) = s; }
        }
    }
};
struct EpiStore {
    static constexpr bool PERM = true, AFTER_DRAIN = false;
    bf16_t* O; int ldc;
    __device__ __forceinline__ void operator()(const pg8::f32x4 (&acc)[2][2][4][2], const pg8::Unit& u, int wr, int wc, int fr, int fq) const {
        const int row0 = u.pm * 256 + wr * 64 + fr; const int colt = u.pn * 256 + wc * 32 + 8 * fq;
#pragma unroll
        for (int ai = 0; ai < 2; ++ai)
#pragma unroll
            for (int m = 0; m < 4; ++m) { bf16_t* rowp = O + (size_t)(row0 + ai * 128 + m * 16) * ldc + colt;
#pragma unroll
                for (int bj = 0; bj < 2; ++bj) { const pg8::f32x4 v0 = acc[ai][bj][m][0], v1 = acc[ai][bj][m][1];
                    u32x4 w; w.x = pk2(v0[0], v0[1]); w.y = pk2(v0[2], v0[3]); w.z = pk2(v1[0], v1[1]); w.w = pk2(v1[2], v1[3]);
                    *(u32x4*)(rowp + bj * 128) = w; } }
    }
};
__device__ __forceinline__ f32x4 shfl4(f32x4 v, int src) { f32x4 r; r[0] = __shfl(v[0], src); r[1] = __shfl(v[1], src); r[2] = __shfl(v[2], src); r[3] = __shfl(v[3], src); return r; }
__device__ __forceinline__ f32x4 gate4(f32x4 u, f32x4 g) { f32x4 r;
#pragma unroll
    for (int j = 0; j < 4; ++j) { const float e = __builtin_amdgcn_exp2f(-g[j] * LOG2E); r[j] = u[j] * g[j] * __builtin_amdgcn_rcpf(1.f + e); }
    return r; }
struct EpiUp {
    static constexpr bool PERM = true, AFTER_DRAIN = false;
    bf16_t* ACT; float* Z4; const float* cw; const float* cb;
    __device__ __forceinline__ void operator()(const pg8::f32x4 (&acc)[2][2][4][2], const pg8::Unit& u, int wr, int wc, int fr, int fq) const {
        const int src1 = (fq << 4) | ((fr - 1) & 15), src2 = (fq << 4) | ((fr - 2) & 15);
#pragma unroll
        for (int n = 0; n < 2; ++n) {
            const int ch = 128 * u.pn + 32 * wc + 8 * fq + 4 * n; const int tcol = 256 * u.pn + 32 * wc + 8 * fq + 4 * n;
#pragma unroll
            for (int ai = 0; ai < 2; ++ai) {
                const int sb = 4 * u.pm + 2 * ai + wr;
                if (fr < 2) { float* z = Z4 + ((size_t)sb * 4 + fr) * NUP + tcol; *(f32x4*)z = acc[ai][0][0][n]; *(f32x4*)(z + 128) = acc[ai][1][0][n]; }
                if (fr >= 14) { float* z = Z4 + ((size_t)sb * 4 + fr - 12) * NUP + tcol; *(f32x4*)z = acc[ai][0][3][n]; *(f32x4*)(z + 128) = acc[ai][1][3][n]; }
                f32x4 pr1u = {0.f, 0.f, 0.f, 0.f}, pr2u = pr1u, pr1g = pr1u, pr2g = pr1u;
#pragma unroll
                for (int m = 0; m < 4; ++m) {
                    f32x4 sg;
                    { const f32x4 w0 = *(const f32x4*)(cw + DFF + ch), w1 = *(const f32x4*)(cw + NUP + DFF + ch), w2 = *(const f32x4*)(cw + 2 * NUP + DFF + ch), bb = *(const f32x4*)(cb + DFF + ch);
                      const f32x4 zg = acc[ai][1][m][n]; const f32x4 r1 = shfl4(zg, src1), r2 = shfl4(zg, src2);
                      const f32x4 p1 = fr >= 1 ? r1 : pr1g, p2 = fr >= 2 ? r2 : pr2g; pr1g = r1; pr2g = r2;
                      const f32x4 up = bb + w2 * zg + w1 * p1 + w0 * p2;
#pragma unroll
                      for (int j = 0; j < 4; ++j) sg[j] = up[j] * __builtin_amdgcn_rcpf(1.f + __builtin_amdgcn_exp2f(-up[j] * LOG2E)); }
                    asm volatile("" : "+v"(sg));
                    { const f32x4 w0 = *(const f32x4*)(cw + ch), w1 = *(const f32x4*)(cw + NUP + ch), w2 = *(const f32x4*)(cw + 2 * NUP + ch), bb = *(const f32x4*)(cb + ch);
                      const f32x4 zu = acc[ai][0][m][n]; const f32x4 r1 = shfl4(zu, src1), r2 = shfl4(zu, src2);
                      const f32x4 p1 = fr >= 1 ? r1 : pr1u, p2 = fr >= 2 ? r2 : pr2u; pr1u = r1; pr2u = r2;
                      const f32x4 o = (bb + w2 * zu + w1 * p1 + w0 * p2) * sg;
                      if (m > 0 || fr >= 2) { u32x2 w; w.x = pk2(o[0], o[1]); w.y = pk2(o[2], o[3]); *(u32x2*)(ACT + (size_t)(64 * sb + 16 * m + fr) * DFF + ch) = w; } }
                    asm volatile("" ::: "memory");
                }
            }
        }
    }
};
__device__ __forceinline__ void fixup_pass(bf16_t* ACT, const float* Z4, const float* cw, const float* cb, int gtid, int NGT) {
    for (int it = gtid; it < 512 * 704; it += NGT) {
        const int sb = it / 704, ch = 4 * (it % 704); const int tcol = 256 * (ch >> 7) + (ch & 127);
        const float* z = Z4 + (size_t)sb * 4 * NUP + tcol;
        const f32x4 z0u = *(const f32x4*)z, z0g = *(const f32x4*)(z + 128), z1u = *(const f32x4*)(z + NUP), z1g = *(const f32x4*)(z + NUP + 128);
        f32x4 a62u = {0.f, 0.f, 0.f, 0.f}, a62g = a62u, a63u = a62u, a63g = a62u;
        if (sb & 31) { const float* zp = z - 2 * NUP; a62u = *(const f32x4*)zp; a62g = *(const f32x4*)(zp + 128); a63u = *(const f32x4*)(zp + NUP); a63g = *(const f32x4*)(zp + NUP + 128); }
        const f32x4 w0u = *(const f32x4*)(cw + ch), w1u = *(const f32x4*)(cw + NUP + ch), w2u = *(const f32x4*)(cw + 2 * NUP + ch), bu = *(const f32x4*)(cb + ch);
        const f32x4 w0g = *(const f32x4*)(cw + DFF + ch), w1g = *(const f32x4*)(cw + NUP + DFF + ch), w2g = *(const f32x4*)(cw + 2 * NUP + DFF + ch), bg = *(const f32x4*)(cb + DFF + ch);
        const f32x4 o0 = gate4(bu + w2u * z0u + w1u * a63u + w0u * a62u, bg + w2g * z0g + w1g * a63g + w0g * a62g);
        const f32x4 o1 = gate4(bu + w2u * z1u + w1u * z0u + w0u * a63u, bg + w2g * z1g + w1g * z0g + w0g * a63g);
        u32x2 w; w.x = pk2(o0[0], o0[1]); w.y = pk2(o0[2], o0[3]); *(u32x2*)(ACT + (size_t)(64 * sb) * DFF + ch) = w;
        w.x = pk2(o1[0], o1[1]); w.y = pk2(o1[2], o1[3]); *(u32x2*)(ACT + (size_t)(64 * sb + 1) * DFF + ch) = w;
    }
}
__device__ __forceinline__ void unpack8(const u32x4 w, float (&f)[8]) { f[0] = bflo(w.x); f[1] = bfhi(w.x); f[2] = bflo(w.y); f[3] = bfhi(w.y); f[4] = bflo(w.z); f[5] = bfhi(w.z); f[6] = bflo(w.w); f[7] = bfhi(w.w); }
__device__ __forceinline__ u32x4 pack8(const float (&f)[8]) { u32x4 w; w.x = pk2(f[0], f[1]); w.y = pk2(f[2], f[3]); w.z = pk2(f[4], f[5]); w.w = pk2(f[6], f[7]); return w; }
__device__ __forceinline__ void mixer_item(const bf16_t* __restrict__ H, bf16_t* __restrict__ A2, const float* __restrict__ convw, int item, int lane) {
    const int b = item >> 7, t0 = (item & 127) << 4; const size_t rb = (size_t)b * SEQ;
    if (lane < 32) {
        const int c = 8 * lane; float w0[8], w1[8], w2[8], pm2[8], pm1[8];
#pragma unroll
        for (int e = 0; e < 8; ++e) { w0[e] = convw[c + e]; w1[e] = convw[256 + c + e]; w2[e] = convw[512 + c + e]; pm2[e] = 0.f; pm1[e] = 0.f; }
        for (int t = t0 - 2; t < t0 + 16; ++t) {
            float pr[8];
            if (t >= 0) { const bf16_t* hr = H + (rb + t) * NIN; float cc[8], cx[8]; unpack8(*(const u32x4*)(hr + 1792 + c), cc); unpack8(*(const u32x4*)(hr + 2048 + c), cx);
#pragma unroll
                for (int e = 0; e < 8; ++e) pr[e] = cc[e] * cx[e]; }
            else {
#pragma unroll
                for (int e = 0; e < 8; ++e) pr[e] = 0.f; }
            if (t >= t0) { float cbv[8], o[8]; unpack8(*(const u32x4*)(H + (rb + t) * NIN + 1536 + c), cbv);
#pragma unroll
                for (int e = 0; e < 8; ++e) o[e] = cbv[e] * (w0[e] * pm2[e] + w1[e] * pm1[e] + w2[e] * pr[e]);
                *(u32x4*)(A2 + (rb + t) * DM + 512 + c) = pack8(o); }
#pragma unroll
            for (int e = 0; e < 8; ++e) { pm2[e] = pm1[e]; pm1[e] = pr[e]; }
        }
    } else {
        const int c = 8 * (lane - 32), w = 2 << (c >> 6); float S[8];
#pragma unroll
        for (int e = 0; e < 8; ++e) S[e] = 0.f;
        for (int t = t0 - w + 1; t < t0; ++t) if (t >= 0) { float p[8]; unpack8(*(const u32x4*)(H + (rb + t) * NIN + 2304 + c), p);
#pragma unroll
            for (int e = 0; e < 8; ++e) S[e] += p[e]; }
        for (int t = t0; t < t0 + 16; ++t) {
            float p[8], o[8]; unpack8(*(const u32x4*)(H + (rb + t) * NIN + 2304 + c), p);
            const float inv = 1.f / (float)((t + 1) < w ? (t + 1) : w);
#pragma unroll
            for (int e = 0; e < 8; ++e) { S[e] += p[e]; o[e] = S[e] * inv - p[e]; }
            *(u32x4*)(A2 + (rb + t) * DM + 768 + c) = pack8(o);
            if (t - w + 1 >= 0) { float q[8]; unpack8(*(const u32x4*)(H + (rb + t - w + 1) * NIN + 2304 + c), q);
#pragma unroll
                for (int e = 0; e < 8; ++e) S[e] -= q[e]; }
        }
    }
}

constexpr int AL_K = 0, AL_V = 32768, AL_TAB = 32768 + 64 * 528, AL_KM = AL_TAB + 2304 * 4, V_STRIDE = 528;
__device__ __forceinline__ int t5_bucket(int n) {
    if (n < 16) return n;
    return 15 + (n >= 16) + (n >= 21) + (n >= 27) + (n >= 35) + (n >= 46) + (n >= 59) + (n >= 77) + (n >= 99) + (n >= 128) + (n >= 166) + (n >= 216) + (n >= 280) + (n >= 363) + (n >= 470) + (n >= 609) + (n >= 790);
}
template <bool OWN>
__device__ __forceinline__ void attn_block(LAS unsigned char* lds, const bf16x8 (&qr)[4], f32x16 (&o)[2], float& m_run, float& l_run, int distbase, bool selected, int wid, int r32, int hi) {
    if (!OWN) { if (!__any(selected)) return; }
    const LAS unsigned char* Kl = lds + AL_K; const LAS unsigned char* Vl = lds + AL_V; const LAS float* tab = (const LAS float*)(lds + AL_TAB);
    const int pi = (r32 & 19) | ((r32 & 4) << 1) | ((r32 & 8) >> 1);
    const int ql = 32 * wid + r32;
#pragma unroll 1
    for (int t = 0; t < 4; ++t) {
        if (OWN && 64 * t > 32 * wid + 31) break;
        f32x16 p0, p1;
#pragma unroll
        for (int r = 0; r < 16; ++r) { p0[r] = 0.f; p1[r] = 0.f; }
        const int kv0 = 64 * t + pi;
#pragma unroll
        for (int d0 = 0; d0 < 4; ++d0) {
            const int c = 2 * d0 + hi; const int addr = kv0 * 128 + ((c ^ ((kv0 >> 1) & 7)) << 4);
            const bf16x8 a0 = *(const LAS bf16x8*)(Kl + addr), a1 = *(const LAS bf16x8*)(Kl + addr + 32 * 128);
            p0 = __builtin_amdgcn_mfma_f32_32x32x16_bf16(a0, qr[d0], p0, 0, 0, 0);
            p1 = __builtin_amdgcn_mfma_f32_32x32x16_bf16(a1, qr[d0], p1, 0, 0, 0);
        }
        const int dist0 = distbase + ql - 64 * t - 8 * hi;
        const LAS float* tb = tab + 256 + dist0;
        float tmax = NEGBIG;
#pragma unroll
        for (int r = 0; r < 16; ++r) { const int off = (r & 7) + 16 * (r >> 3);
            float s0 = p0[r] * C2 + tb[-off], s1 = p1[r] * C2 + tb[-off - 32];
            if (OWN) { if (dist0 - off < 0) s0 = NEGBIG; if (dist0 - off - 32 < 0) s1 = NEGBIG; }
            else { if (!selected) { s0 = NEGBIG; s1 = NEGBIG; } }
            p0[r] = s0; p1[r] = s1; tmax = fmaxf(tmax, fmaxf(s0, s1)); }
        tmax = fmaxf(tmax, __shfl_xor(tmax, 32));
        const float m_new = fmaxf(m_run, tmax);
        if (__any(m_new > m_run)) { const float al = __builtin_amdgcn_exp2f(m_run - m_new); l_run *= al;
#pragma unroll
            for (int r = 0; r < 16; ++r) { o[0][r] *= al; o[1][r] *= al; } }
        m_run = m_new;
        float ls = 0.f;
#pragma unroll
        for (int r = 0; r < 16; ++r) { p0[r] = __builtin_amdgcn_exp2f(p0[r] - m_new); p1[r] = __builtin_amdgcn_exp2f(p1[r] - m_new); ls += p0[r] + p1[r]; }
        l_run += ls;
        u32x4 pk[4];
        pk[0] = (u32x4){pk2(p0[0], p0[1]), pk2(p0[2], p0[3]), pk2(p0[4], p0[5]), pk2(p0[6], p0[7])};
        pk[1] = (u32x4){pk2(p0[8], p0[9]), pk2(p0[10], p0[11]), pk2(p0[12], p0[13]), pk2(p0[14], p0[15])};
        pk[2] = (u32x4){pk2(p1[0], p1[1]), pk2(p1[2], p1[3]), pk2(p1[4], p1[5]), pk2(p1[6], p1[7])};
        pk[3] = (u32x4){pk2(p1[8], p1[9]), pk2(p1[10], p1[11]), pk2(p1[12], p1[13]), pk2(p1[14], p1[15])};
#pragma unroll
        for (int d0 = 0; d0 < 2; ++d0)
#pragma unroll
            for (int g = 0; g < 4; ++g) { const bf16x8 vf = *(const LAS bf16x8*)(Vl + (32 * d0 + r32) * V_STRIDE + (64 * t + 16 * g + 8 * hi) * 2);
                o[d0] = __builtin_amdgcn_mfma_f32_32x32x16_bf16(vf, __builtin_bit_cast(bf16x8, pk[g]), o[d0], 0, 0, 0); }
    }
}
__device__ __forceinline__ void attn_unit(LAS unsigned char* lds, const bf16_t* __restrict__ H, const bf16_t* __restrict__ VT, const float* __restrict__ kpart, const float* __restrict__ relb,
                                          bf16_t* __restrict__ A2, int b, int h, int i) {
    int tid_ = threadIdx.x; asm volatile("" : "+v"(tid_));
    const int tid = tid_, lane = tid & 63, wid = __builtin_amdgcn_readfirstlane(tid >> 6), r32 = lane & 31, hi = lane >> 5;
    LAS float* tab = (LAS float*)(lds + AL_TAB); LAS float* km = (LAS float*)(lds + AL_KM);
    __syncthreads();
    for (int e = tid; e < 2304; e += NTHREADS) { const int dist = e - 256; tab[e] = relb[h * 32 + t5_bucket(dist < 0 ? 0 : dist)] * LOG2E; }
    if (tid < i * 64) { const int j = tid >> 6, d = tid & 63; const float* kp = kpart + (size_t)((b * 8 + j) * 2) * 512 + h * 64 + d; km[tid] = (kp[0] + kp[512]) * (1.f / 256.f); }
    const size_t rowQ = (size_t)b * SEQ + i * 256 + wid * 32 + r32;
    bf16x8 qr[4];
#pragma unroll
    for (int d0 = 0; d0 < 4; ++d0) qr[d0] = *(const bf16x8*)(H + rowQ * NIN + h * 64 + 16 * d0 + 8 * hi);
#define ATT_LOAD(j) do { _Pragma("unroll") for (int k_ = 0; k_ < 4; ++k_) { const int p_ = tid + 512 * k_; \
        kreg[k_] = *(const u32x4*)(H + ((size_t)b * SEQ + (j) * 256 + (p_ >> 3)) * NIN + 512 + h * 64 + 8 * (p_ & 7)); \
        vreg[k_] = *(const u32x4*)(VT + ((size_t)(b * 8 + h) * 64 + (p_ >> 5)) * SEQ + (j) * 256 + 8 * (p_ & 31)); } } while (0)
#define ATT_STORE() do { _Pragma("unroll") for (int k_ = 0; k_ < 4; ++k_) { const int p_ = tid + 512 * k_; const int kv_ = p_ >> 3, c_ = p_ & 7; \
        *(LAS u32x4*)(lds + AL_K + kv_ * 128 + ((c_ ^ ((kv_ >> 1) & 7)) << 4)) = kreg[k_]; \
        *(LAS u32x4*)(lds + AL_V + (p_ >> 5) * V_STRIDE + 16 * (p_ & 31)) = vreg[k_]; } } while (0)
    { u32x4 kreg[4], vreg[4]; ATT_LOAD(i); ATT_STORE(); }
    __syncthreads();
    unsigned sel;
    {
        float g[7];
#pragma unroll
        for (int j = 0; j < 7; ++j) { float s = 0.f;
            if (j < i) {
#pragma unroll
                for (int d0 = 0; d0 < 4; ++d0)
#pragma unroll
                    for (int e = 0; e < 8; ++e) s += bf2f((unsigned short)qr[d0][e]) * km[j * 64 + 16 * d0 + 8 * hi + e]; }
            g[j] = s + __shfl_xor(s, 32); }
        if (i <= 3) sel = (1u << i) - 1u;
        else { sel = 0u;
#pragma unroll
            for (int s = 0; s < 3; ++s) { float best = -3.0e38f; int bj = 0;
#pragma unroll
                for (int j = 0; j < 7; ++j) { const bool ok = (j < i) && !((sel >> j) & 1u) && (g[j] > best); best = ok ? g[j] : best; bj = ok ? j : bj; }
                sel |= 1u << bj; } }
    }
    f32x16 o[2];
#pragma unroll
    for (int r = 0; r < 16; ++r) { o[0][r] = 0.f; o[1][r] = 0.f; }
    float m_run = NEGBIG, l_run = 0.f;
    attn_block<true>(lds, qr, o, m_run, l_run, 0, true, wid, r32, hi);
#pragma unroll 1
    for (int j = 0; j < i; ++j) {
        __syncthreads();
        { u32x4 kreg[4], vreg[4]; ATT_LOAD(j); ATT_STORE(); }
        __syncthreads();
        attn_block<false>(lds, qr, o, m_run, l_run, (i - j) * 256, ((sel >> j) & 1u) != 0u, wid, r32, hi);
    }
#undef ATT_LOAD
#undef ATT_STORE
    const float inv = 1.f / (l_run + __shfl_xor(l_run, 32));
    bf16_t* orow = A2 + rowQ * DM + h * 64 + 4 * hi;
#pragma unroll
    for (int d0 = 0; d0 < 2; ++d0)
#pragma unroll
        for (int rq = 0; rq < 4; ++rq) { u32x2 w; w.x = pk2(o[d0][4 * rq] * inv, o[d0][4 * rq + 1] * inv); w.y = pk2(o[d0][4 * rq + 2] * inv, o[d0][4 * rq + 3] * inv);
            *(u32x2*)(orow + 32 * d0 + 8 * rq) = w; }
}

#define XB_TMO      128
#define XB_XCNT(j)  (256  + 64 * (j))
#define XB_XSUB(j)  (1280 + 64 * (j))
#define XB_XGEN(j)  (2304 + 64 * (j))
#define XB_TOP      3328
#define XB_TOPGEN   3392
#define XCD_BAR_WORDS 3456
#define XB_SPIN_CAP (1u << 18)

__device__ __forceinline__ unsigned xb_ld(unsigned* p)              { return __hip_atomic_load(p, __ATOMIC_RELAXED, __HIP_MEMORY_SCOPE_AGENT); }
__device__ __forceinline__ unsigned xb_add(unsigned* p, unsigned v) { return __hip_atomic_fetch_add(p, v, __ATOMIC_RELAXED, __HIP_MEMORY_SCOPE_AGENT); }
__device__ __forceinline__ unsigned xb_xcc_id() { return (unsigned)__builtin_amdgcn_s_getreg((3 << 11) | 20) & 0xFu; }
#define XB_SPIN(cond, bar) do { unsigned _sp = 0; while (cond) { __builtin_amdgcn_s_sleep(1); \
    if ((++_sp & 255u) == 0u) { if (xb_ld(&(bar)[XB_TMO])) break; if (_sp > XB_SPIN_CAP) { atomicAdd(&(bar)[XB_TMO], 1u); break; } } } } while (0)

struct XcdBarrier {
    unsigned* bar; unsigned x;
    volatile LAS unsigned* st;
};

__device__ __forceinline__ XcdBarrier xcd_barrier_post(unsigned* bar, volatile LAS unsigned* st) {
    XcdBarrier b; b.bar = bar; b.x = xb_xcc_id(); b.st = st;
    if (threadIdx.x == 0) (void)xb_add(&bar[XB_XCNT(b.x)], 1u);
    return b;
}
__device__ __forceinline__ void xcd_barrier_complete(unsigned* bar, unsigned x, unsigned& nloc, unsigned& nx) {
    const unsigned G = gridDim.x * gridDim.y * gridDim.z;
    unsigned sum, cnt, mine, sp = 0u;
    for (;;) {
        sum = 0u; cnt = 0u; mine = 0u;
#pragma unroll
        for (unsigned j = 0; j < 16; ++j) { const unsigned c = xb_ld(&bar[XB_XCNT(j)]); sum += c; cnt += (c > 0u) ? 1u : 0u; mine = (j == x) ? c : mine; }
        if (sum == G) break;
        __builtin_amdgcn_s_sleep(1);
        if ((++sp & 255u) == 0u) { if (xb_ld(&bar[XB_TMO])) break; if (sp > XB_SPIN_CAP) { atomicAdd(&bar[XB_TMO], 1u); break; } }
    }
    nloc = mine > 0u ? mine : 1u; nx = cnt > 0u ? cnt : 1u;
}

__device__ __forceinline__ void xcd_barrier(const XcdBarrier& b) {
    asm volatile("s_waitcnt vmcnt(0)" ::: "memory");
    __syncthreads();
    if (threadIdx.x == 0) {
        unsigned* bar = b.bar;
        __builtin_amdgcn_s_waitcnt(0);
        unsigned nloc = b.st[0], nx = b.st[1];
        if (nloc == 0u) { xcd_barrier_complete(bar, b.x, nloc, nx); b.st[0] = nloc; b.st[1] = nx; }
        const unsigned old = xb_add(&bar[XB_XSUB(b.x)], 1u);
        const unsigned gen = old / nloc;
        if (old + 1u == (gen + 1u) * nloc) {
            __builtin_amdgcn_fence(__ATOMIC_RELEASE, "agent");
            asm volatile("s_waitcnt vmcnt(0)" ::: "memory");
            const unsigned og = xb_add(&bar[XB_TOP], 1u);
            const unsigned tg = og / nx;
            if (og + 1u == (tg + 1u) * nx) xb_add(&bar[XB_TOPGEN], 1u);
            else XB_SPIN(xb_ld(&bar[XB_TOPGEN]) == tg, bar);
            __builtin_amdgcn_fence(__ATOMIC_ACQUIRE, "agent");
            xb_add(&bar[XB_XGEN(b.x)], 1u);
            asm volatile("s_waitcnt vmcnt(0)" ::: "memory");
        } else {
            XB_SPIN(xb_ld(&bar[XB_XGEN(b.x)]) == gen, bar);
            __builtin_amdgcn_fence(__ATOMIC_ACQUIRE, "agent");
            asm volatile("s_waitcnt vmcnt(0)" ::: "memory");
        }
    }
    __syncthreads();
}

constexpr int TBL_OFF = LDS_BYTES - 256;
__device__ __forceinline__ unsigned char* ldp(LAS unsigned char* lds, int idx) {
    const unsigned lo = *(volatile LAS unsigned*)(lds + TBL_OFF + 8 * idx), hi = *(volatile LAS unsigned*)(lds + TBL_OFF + 8 * idx + 4);
    return (unsigned char*)(((unsigned long long)(unsigned)__builtin_amdgcn_readfirstlane((int)hi) << 32) | (unsigned long long)(unsigned)__builtin_amdgcn_readfirstlane((int)lo));
}
__global__ void __launch_bounds__(NTHREADS, 2) hymba_fwd(Args a) {
    extern __shared__ __attribute__((aligned(16))) unsigned char lds_raw[];
    LAS unsigned char* lds = (LAS unsigned char*)lds_raw;
    cg::grid_group grid = cg::this_grid();
    const int tid = threadIdx.x, lane = tid & 63, wave = __builtin_amdgcn_readfirstlane(tid >> 6);
    const int G = gridDim.x, bx = blockIdx.x;
    const int gw = bx * NWAVES + wave, NGW = G * NWAVES;
    if (tid == 0) { LAS unsigned long long* T = (LAS unsigned long long*)(lds + TBL_OFF);
        T[0] = (unsigned long long)a.x; T[1] = (unsigned long long)a.w_in; T[2] = (unsigned long long)a.conv_w; T[3] = (unsigned long long)a.w_pool; T[4] = (unsigned long long)a.pool_scale;
        T[5] = (unsigned long long)a.w_out; T[6] = (unsigned long long)a.ln1_g; T[7] = (unsigned long long)a.ln1_b; T[8] = (unsigned long long)a.w_up; T[9] = (unsigned long long)a.ffn_conv_w;
        T[10] = (unsigned long long)a.ffn_conv_b; T[11] = (unsigned long long)a.w_down; T[12] = (unsigned long long)a.ln2_g; T[13] = (unsigned long long)a.ln2_b; T[14] = (unsigned long long)a.rel_bias;
        T[15] = (unsigned long long)a.out; T[16] = (unsigned long long)a.ws; }
    if (tid == 0) { *(LAS unsigned*)(lds + TBL_OFF + 192) = 0u; *(LAS unsigned*)(lds + TBL_OFF + 196) = 0u; }
    if (bx == 0) { unsigned* bw = (unsigned*)(a.ws + WS_BAR); for (int e = tid; e < XCD_BAR_WORDS; e += NTHREADS) __hip_atomic_store(bw + e, 0u, __ATOMIC_RELAXED, __HIP_MEMORY_SCOPE_AGENT); }
    prologue(a, lds, gw, NGW, wave, lane);
    __syncthreads();
    grid.sync();
    XcdBarrier xbar = xcd_barrier_post((unsigned*)(a.ws + WS_BAR), (volatile LAS unsigned*)(lds + TBL_OFF + 192));

#pragma unroll 1
    for (int l = 0; l < DEPTH; ++l) {
        int tid = threadIdx.x; asm volatile("" : "+v"(tid)); const int lane = tid & 63;
#ifndef SKIP_P1
        { unsigned char* ws = ldp(lds, 16);
          pg8::Gemm g{(const bf16_t*)(ws + WS_XB), (const bf16_t*)(ws + WS_WIN) + (size_t)l * WIN_L, MTOK, NIN, DM}; pg8::StaticOrder S; S.init(MTOK, NIN, G, bx);
          EpiH E{(bf16_t*)(ws + WS_H), (bf16_t*)(ws + WS_VT), (float*)(ws + WS_KP)};
          pg8::gemm_phase<EpiH, pg8::StaticOrder, true, true>(lds, g, S, E); }
#endif
        GRID_SYNC();
#ifndef SKIP_P2
        { unsigned char* ws = ldp(lds, 16); const bf16_t* H = (const bf16_t*)(ws + WS_H); bf16_t* A2 = (bf16_t*)(ws + WS_A2);
          { const float* cw = (const float*)ldp(lds, 2) + (size_t)l * 768;
            for (int it = gw; it < BATCH * 128; it += NGW) mixer_item(H, A2, cw, it, lane); }
          const bf16_t* VT = (const bf16_t*)(ws + WS_VT); const float* KP = (const float*)(ws + WS_KP); const float* relb = (const float*)ldp(lds, 14);
#pragma unroll 1
          for (int rep_ = 0; rep_ < REP_P2; ++rep_)
#pragma unroll 1
          for (int p = 2 * bx; p < 1024; p += 2 * G) {
#pragma unroll 1
              for (int uu = 0; uu < 2; ++uu) { const int bh = p >> 3, s = (p >> 1) & 3;
                  attn_unit(lds, H, VT, KP, relb, A2, bh >> 3, bh & 7, uu ? s : 7 - s); } }
          __syncthreads(); }
#endif
        GRID_SYNC();
#ifndef SKIP_P3
        { unsigned char* ws = ldp(lds, 16);
          pg8::Gemm g{(const bf16_t*)(ws + WS_A2), (const bf16_t*)(ws + WS_WOUT) + (size_t)l * WOUT_L, MTOK, DM, DM}; pg8::StaticOrder S; S.init(MTOK, DM, G, bx);
          EpiStore E{(bf16_t*)(ws + WS_MIX), DM};
          pg8::gemm_phase<EpiStore, pg8::StaticOrder, true, true>(lds, g, S, E); }
#endif
        GRID_SYNC();
        { unsigned char* ws = ldp(lds, 16); float* out = (float*)ldp(lds, 15); const float* xin = l == 0 ? (const float*)ldp(lds, 0) : out;
          ln_pass(xin, (const bf16_t*)(ws + WS_MIX), out, (const float*)ldp(lds, 6) + l * DM, (const float*)ldp(lds, 7) + l * DM, (bf16_t*)(ws + WS_XB), gw, NGW, lane); }
        GRID_SYNC();
#ifndef SKIP_P5
        { unsigned char* ws = ldp(lds, 16);
          pg8::Gemm g{(const bf16_t*)(ws + WS_XB), (const bf16_t*)(ws + WS_WUP) + (size_t)l * WUP_L, MTOK, NUP, DM}; pg8::StaticOrder S; S.init(MTOK, NUP, G, bx);
          EpiUp E{(bf16_t*)(ws + WS_ACT), (float*)(ws + WS_Z4), (const float*)ldp(lds, 9) + (size_t)l * 3 * NUP, (const float*)ldp(lds, 10) + (size_t)l * NUP};
          pg8::gemm_phase<EpiUp, pg8::StaticOrder, true, true>(lds, g, S, E); }
#endif
        GRID_SYNC();
        { unsigned char* ws = ldp(lds, 16);
          fixup_pass((bf16_t*)(ws + WS_ACT), (const float*)(ws + WS_Z4), (const float*)ldp(lds, 9) + (size_t)l * 3 * NUP, (const float*)ldp(lds, 10) + (size_t)l * NUP, bx * NTHREADS + tid, G * NTHREADS); }
        GRID_SYNC();
#ifndef SKIP_P7
        { unsigned char* ws = ldp(lds, 16);
          pg8::Gemm g{(const bf16_t*)(ws + WS_ACT), (const bf16_t*)(ws + WS_WDN) + (size_t)l * WDN_L, MTOK, DM, DFF}; pg8::StaticOrder S; S.init(MTOK, DM, G, bx);
          EpiStore E{(bf16_t*)(ws + WS_MIX), DM};
          pg8::gemm_phase<EpiStore, pg8::StaticOrder, true, true>(lds, g, S, E); }
#endif
        GRID_SYNC();
        { unsigned char* ws = ldp(lds, 16); float* out = (float*)ldp(lds, 15);
          ln_pass(out, (const bf16_t*)(ws + WS_MIX), out, (const float*)ldp(lds, 12) + l * DM, (const float*)ldp(lds, 13) + l * DM, (bf16_t*)(ws + WS_XB), gw, NGW, lane); }
        if (l + 1 < DEPTH) GRID_SYNC();
    }
}

extern "C" void kernel_launch(void* const* d_in, const int* in_sizes, int n_in, void* d_out, int out_size, void* d_ws, size_t ws_size, hipStream_t stream) {
    static int grid = 0;
    if (grid == 0) {
        if (n_in != 15 || in_sizes[0] != MTOK * DM || out_size != MTOK * DM || ws_size < WS_END) { fprintf(stderr, "kernel_launch: unexpected shapes (n_in %d, ws %zu)\n", n_in, ws_size); grid = -1; return; }
        int dev = 0, cus = 0, per_cu = 0;
        hipGetDevice(&dev); hipDeviceGetAttribute(&cus, hipDeviceAttributeMultiprocessorCount, dev);
        if (hipFuncSetAttribute((const void*)hymba_fwd, hipFuncAttributeMaxDynamicSharedMemorySize, LDS_BYTES) != hipSuccess) { fprintf(stderr, "kernel_launch: hipFuncSetAttribute failed\n"); grid = -1; return; }
        if (hipOccupancyMaxActiveBlocksPerMultiprocessor(&per_cu, (const void*)hymba_fwd, NTHREADS, LDS_BYTES) != hipSuccess || per_cu < 1) { fprintf(stderr, "kernel_launch: occupancy query says %d\n", per_cu); per_cu = 1; }
        (void)hipGetLastError();
        grid = cus;
    }
    if (grid < 0) return;
    Args a{};
    const float** f = (const float**)&a;
    for (int i = 0; i < 15; ++i) f[i] = (const float*)d_in[i];
    a.out = (float*)d_out; a.ws = (unsigned char*)d_ws;
    void* args[] = {&a};
    hipError_t e = hipLaunchCooperativeKernel((const void*)hymba_fwd, dim3(grid), dim3(NTHREADS), args, LDS_BYTES, stream);
    if (e != hipSuccess) fprintf(stderr, "kernel_launch: cooperative launch failed: %s (grid %d)\n", hipGetErrorString(e), grid);
}
```
